# Optimizing an MI355X kernel written in HIP

```python
import jax, jax.numpy as jnp
from jax import lax
import numpy as np

D_MODEL = 1024
BATCH = 4
SEQ = 8192
DEPTH = 2

GRID_W = 64
CTX_LEN = 256
EPS = 1e-6

D_CONV = 256
CONV_GROUPS = 4
CONV_W = 3
D_SGU = 256
SGU_HEADS = 4
SGU_HEAD_DIM = D_SGU // SGU_HEADS
SGU_CHUNK = 128
N_HEADS = 8
N_KV_HEADS = 2
HEAD_DIM = 64
Q_PER_KV = N_HEADS // N_KV_HEADS
D_ATTN = N_HEADS * HEAD_DIM
WINDOW = 128
BLOCK = 128
ROPE_THETA = 10000.0
ROPE_AXIS_DIM = HEAD_DIM // 2
ROPE_FREQS = ROPE_AXIS_DIM // 2
D_MIX = D_CONV + D_SGU + D_ATTN

CONV_END = 3 * D_CONV
SGU_END = CONV_END + 2 * D_SGU
Q_END = SGU_END + D_ATTN
K_END = Q_END + N_KV_HEADS * HEAD_DIM
D_IN = K_END + N_KV_HEADS * HEAD_DIM

N_KEYS = 128
N_EXPERTS = N_KEYS * N_KEYS
PEER_HEADS = 8
PEER_TOPK = 16
PEER_DQ = 256
PEER_DHALF = PEER_DQ // 2
EXPERT_CHUNK = 128

kernel_name = "hybrid_parallel_heads_peer_dit"


def rmsnorm(x, g):
    xf = x.astype(jnp.float32)
    y = xf * lax.rsqrt(jnp.mean(xf * xf, axis=-1, keepdims=True) + EPS)
    return (y * g.astype(jnp.float32)).astype(x.dtype)


def rms_plain(x):
    xf = x.astype(jnp.float32)
    return (xf * lax.rsqrt(jnp.mean(xf * xf, axis=-1, keepdims=True) + EPS)).astype(x.dtype)


def layernorm(x, g):
    xf = x.astype(jnp.float32)
    mu = jnp.mean(xf, axis=-1, keepdims=True)
    var = jnp.mean(jnp.square(xf - mu), axis=-1, keepdims=True)
    return ((xf - mu) * lax.rsqrt(var + EPS) * g.astype(jnp.float32)).astype(x.dtype)


def axial_rope_tables(L):
    rows = L // GRID_W
    row = jnp.repeat(jnp.arange(rows), GRID_W).astype(jnp.float32)
    col = jnp.tile(jnp.arange(GRID_W), rows).astype(jnp.float32)
    inv = ROPE_THETA ** (-jnp.arange(ROPE_FREQS, dtype=jnp.float32) / ROPE_FREQS)
    ar = row[:, None] * inv[None, :]
    ac = col[:, None] * inv[None, :]
    ang = jnp.concatenate([ar, ar, ac, ac], axis=-1)
    return jnp.cos(ang), jnp.sin(ang)


def apply_rope(x, cos, sin):
    f = ROPE_FREQS
    xf = x.astype(jnp.float32)
    x1, x2, x3, x4 = xf[..., :f], xf[..., f:2 * f], xf[..., 2 * f:3 * f], xf[..., 3 * f:]
    rot = jnp.concatenate([-x2, x1, -x4, x3], axis=-1)
    return (xf * cos[None, :, None, :] + rot * sin[None, :, None, :]).astype(x.dtype)


def short_conv(p, w):
    b_gate, c_gate, xin = jnp.split(p, 3, axis=-1)
    z = c_gate * xin
    zp = jnp.pad(z, ((0, 0), (1, 1), (0, 0)))
    y = zp[:, :-2] * w[0] + zp[:, 1:-1] * w[1] + zp[:, 2:] * w[2]
    return b_gate * y


def spatial_gating(p, g_norm, w_s, b_s):
    B_, S, _ = p.shape
    z = jax.nn.gelu(p)
    u, v = jnp.split(z, 2, axis=-1)
    v = layernorm(v, g_norm)
    v = v.reshape(B_, S // SGU_CHUNK, SGU_CHUNK, SGU_HEADS, SGU_HEAD_DIM)
    s = jnp.einsum('hpq,bnqhc->bnphc', w_s, v) + b_s.T[None, None, :, :, None]
    return u * s.reshape(B_, S, D_SGU)


def windowed_attention(q, k, v, kc, vc, sink):
    B_, L = q.shape[:2]
    nb = L // BLOCK
    scale = HEAD_DIM ** -0.5
    qb = q.reshape(B_, nb, BLOCK, N_KV_HEADS, Q_PER_KV, HEAD_DIM)
    pad = ((0, 0), (BLOCK, BLOCK), (0, 0), (0, 0))
    kp = jnp.pad(k, pad).reshape(B_, nb + 2, BLOCK, N_KV_HEADS, HEAD_DIM)
    vp = jnp.pad(v, pad).reshape(B_, nb + 2, BLOCK, N_KV_HEADS, HEAD_DIM)
    kb = jnp.concatenate([kp[:, :-2], kp[:, 1:-1], kp[:, 2:]], axis=2)
    vb = jnp.concatenate([vp[:, :-2], vp[:, 1:-1], vp[:, 2:]], axis=2)
    s_loc = jnp.einsum('bnqhgd,bnkhd->bnhgqk', qb, kb).astype(jnp.float32) * scale
    s_ctx = jnp.einsum('bnqhgd,bkhd->bnhgqk', qb, kc).astype(jnp.float32) * scale
    qi = jnp.arange(BLOCK)[:, None]
    ki = jnp.arange(3 * BLOCK)[None, :]
    band = jnp.abs(ki - BLOCK - qi) <= WINDOW
    kblock = jnp.arange(nb)[:, None] + ki // BLOCK - 1
    in_range = (kblock >= 0) & (kblock < nb)
    mask = band[None] & in_range[:, None, :]
    s_loc = jnp.where(mask[None, :, None, None], s_loc, -jnp.inf)
    sk = sink.astype(jnp.float32).reshape(N_KV_HEADS, Q_PER_KV)[None, None, :, :, None]
    m = jnp.maximum(jnp.maximum(jnp.max(s_loc, axis=-1), jnp.max(s_ctx, axis=-1)), sk)
    p_loc = jnp.exp(s_loc - m[..., None])
    p_ctx = jnp.exp(s_ctx - m[..., None])
    denom = jnp.sum(p_loc, axis=-1) + jnp.sum(p_ctx, axis=-1) + jnp.exp(sk - m)
    o = (jnp.einsum('bnhgqk,bnkhd->bnhgqd', p_loc, vb.astype(jnp.float32))
         + jnp.einsum('bnhgqk,bkhd->bnhgqd', p_ctx, vc.astype(jnp.float32))) / denom[..., None]
    return o.transpose(0, 1, 4, 2, 3, 5).reshape(B_, L, D_ATTN).astype(q.dtype)


def context_attention(qc, kc, vc, sink):
    B_, C = qc.shape[:2]
    scale = HEAD_DIM ** -0.5
    qg = qc.reshape(B_, C, N_KV_HEADS, Q_PER_KV, HEAD_DIM)
    s = jnp.einsum('bqhgd,bkhd->bhgqk', qg, kc).astype(jnp.float32) * scale
    sk = sink.astype(jnp.float32).reshape(N_KV_HEADS, Q_PER_KV)[None, :, :, None]
    m = jnp.maximum(jnp.max(s, axis=-1), sk)
    p = jnp.exp(s - m[..., None])
    denom = jnp.sum(p, axis=-1) + jnp.exp(sk - m)
    o = jnp.einsum('bhgqk,bkhd->bhgqd', p, vc.astype(jnp.float32)) / denom[..., None]
    return o.transpose(0, 3, 1, 2, 4).reshape(B_, C, D_ATTN).astype(qc.dtype)


def merge_groups(y_conv, y_sgu, y_attn, g, w_out):
    y = jnp.concatenate([rms_plain(y_conv), rms_plain(y_sgu), rms_plain(y_attn)], axis=-1)
    return (y * g) @ w_out


def token_mixers(hl, hc, w_in, conv_w, sgu_norm_g, sgu_w, sgu_b, sink, mix_norm_g, w_out,
                 cos, sin, need_ctx):
    B_, L, _ = hl.shape
    C = hc.shape[1]
    pl = hl @ w_in
    conv_l = short_conv(pl[..., :CONV_END], conv_w)
    sgu_l = spatial_gating(pl[..., CONV_END:SGU_END], sgu_norm_g, sgu_w, sgu_b)
    q = apply_rope(pl[..., SGU_END:Q_END].reshape(B_, L, N_HEADS, HEAD_DIM), cos, sin)
    k = apply_rope(pl[..., Q_END:K_END].reshape(B_, L, N_KV_HEADS, HEAD_DIM), cos, sin)
    v = pl[..., K_END:].reshape(B_, L, N_KV_HEADS, HEAD_DIM)
    if need_ctx:
        pc = hc @ w_in
        pkv = pc[..., Q_END:]
    else:
        pkv = hc @ w_in[:, Q_END:]
    kc = pkv[..., :N_KV_HEADS * HEAD_DIM].reshape(B_, C, N_KV_HEADS, HEAD_DIM)
    vc = pkv[..., N_KV_HEADS * HEAD_DIM:].reshape(B_, C, N_KV_HEADS, HEAD_DIM)
    attn_l = windowed_attention(q, k, v, kc, vc, sink)
    yl = merge_groups(conv_l, sgu_l, attn_l, mix_norm_g, w_out)
    if not need_ctx:
        return yl, None
    conv_c = short_conv(pc[..., :CONV_END], conv_w)
    sgu_c = spatial_gating(pc[..., CONV_END:SGU_END], sgu_norm_g, sgu_w, sgu_b)
    qc = pc[..., SGU_END:Q_END].reshape(B_, C, N_HEADS, HEAD_DIM)
    attn_c = context_attention(qc, kc, vc, sink)
    yc = merge_groups(conv_c, sgu_c, attn_c, mix_norm_g, w_out)
    return yl, yc


def peer(h, wq, keys, u_tab, v_tab):
    B_, S, D = h.shape
    T = B_ * S
    t = h.reshape(T, D)
    q = (t @ wq).reshape(T, PEER_HEADS, 2, PEER_DHALF)
    s = jnp.einsum('thpd,hpkd->thpk', q, keys).astype(jnp.float32)
    sv, si = lax.top_k(s, PEER_TOPK)
    cand = (sv[..., 0, :, None] + sv[..., 1, None, :]).reshape(T, PEER_HEADS, PEER_TOPK * PEER_TOPK)
    cidx = (si[..., 0, :, None] * N_KEYS + si[..., 1, None, :]).reshape(T, PEER_HEADS, PEER_TOPK * PEER_TOPK)
    fv, fi = lax.top_k(cand, PEER_TOPK)
    experts = jnp.take_along_axis(cidx, fi, axis=-1)
    gates = jax.nn.softmax(fv, axis=-1).astype(h.dtype)
    nc = T // EXPERT_CHUNK
    experts = experts.reshape(nc, EXPERT_CHUNK, PEER_HEADS * PEER_TOPK)
    gates = gates.reshape(nc, EXPERT_CHUNK, PEER_HEADS * PEER_TOPK)
    tc = t.reshape(nc, EXPERT_CHUNK, D)

    def run(args):
        xc, ec, gc = args
        a = jax.nn.gelu(jnp.einsum('tkd,td->tk', u_tab[ec], xc))
        return jnp.einsum('tk,tkd->td', a * gc, v_tab[ec])

    out = lax.map(run, (tc, experts, gates))
    return out.reshape(B_, S, D)


def setup_inputs(seed: int = 0) -> dict:
    key = jax.random.key(seed)
    ks = jax.random.split(key, 24)
    n = jax.random.normal
    f32 = jnp.float32
    return {
        "x": n(ks[0], (BATCH, SEQ, D_MODEL), f32),
        "c": n(ks[1], (BATCH, D_MODEL), f32),
        "ctx": n(ks[2], (BATCH, CTX_LEN, D_MODEL), f32),
        "c_ctx": n(ks[3], (D_MODEL,), f32),
        "w_ada": n(ks[4], (DEPTH, D_MODEL, 6 * D_MODEL), f32) * (0.5 * D_MODEL ** -0.5),
        "b_ada": n(ks[5], (DEPTH, 6 * D_MODEL), f32) * 0.02,
        "norm1_g": 1.0 + 0.05 * n(ks[6], (DEPTH, D_MODEL), f32),
        "norm2_g": 1.0 + 0.05 * n(ks[7], (DEPTH, D_MODEL), f32),
        "w_in": n(ks[8], (DEPTH, D_MODEL, D_IN), f32) * D_MODEL ** -0.5,
        "conv_w": n(ks[9], (DEPTH, CONV_W, D_CONV), f32) * CONV_W ** -0.5,
        "sgu_norm_g": 1.0 + 0.05 * n(ks[10], (DEPTH, D_SGU), f32),
        "sgu_w": n(ks[11], (DEPTH, SGU_HEADS, SGU_CHUNK, SGU_CHUNK), f32) * SGU_CHUNK ** -0.5,
        "sgu_b": 1.0 + 0.1 * n(ks[12], (DEPTH, SGU_HEADS, SGU_CHUNK), f32),
        "attn_sink": 0.5 * n(ks[13], (DEPTH, N_HEADS), f32),
        "mix_norm_g": 1.0 + 0.05 * n(ks[14], (DEPTH, D_MIX), f32),
        "w_out": n(ks[15], (DEPTH, D_MIX, D_MODEL), f32) * D_MIX ** -0.5,
        "peer_wq": n(ks[16], (DEPTH, D_MODEL, PEER_HEADS * PEER_DQ), f32) * D_MODEL ** -0.5,
        "peer_keys": n(ks[17], (DEPTH, PEER_HEADS, 2, N_KEYS, PEER_DHALF), f32) * PEER_DHALF ** -0.5,
        "peer_u": n(ks[18], (DEPTH, N_EXPERTS, D_MODEL), f32) * D_MODEL ** -0.5,
        "peer_v": n(ks[19], (DEPTH, N_EXPERTS, D_MODEL), f32) * 0.5,
        "final_g": 1.0 + 0.05 * n(ks[20], (D_MODEL,), f32),
    }


def reference(x, c, ctx, c_ctx, w_ada, b_ada, norm1_g, norm2_g, w_in, conv_w, sgu_norm_g, sgu_w,
              sgu_b, attn_sink, mix_norm_g, w_out, peer_wq, peer_keys, peer_u, peer_v, final_g):
    L = x.shape[1]
    C = ctx.shape[1]
    cos, sin = axial_rope_tables(L)
    sc = jax.nn.silu(c)
    scc = jax.nn.silu(c_ctx)
    xl, xc = x, ctx
    for i in range(DEPTH):
        last = i == DEPTH - 1
        mod_l = (sc @ w_ada[i] + b_ada[i])[:, None, :]
        mod_c = scc @ w_ada[i] + b_ada[i]
        sh1, s1, g1, sh2, s2, g2 = jnp.split(mod_l, 6, axis=-1)
        csh1, cs1, cg1, csh2, cs2, cg2 = jnp.split(mod_c, 6, axis=-1)
        hl = rmsnorm(xl, norm1_g[i]) * (1.0 + s1) + sh1
        hc = rmsnorm(xc, norm1_g[i]) * (1.0 + cs1) + csh1
        yl, yc = token_mixers(hl, hc, w_in[i], conv_w[i], sgu_norm_g[i], sgu_w[i], sgu_b[i],
                              attn_sink[i], mix_norm_g[i], w_out[i], cos, sin, not last)
        xl = xl + g1 * yl
        hl = rmsnorm(xl, norm2_g[i]) * (1.0 + s2) + sh2
        if last:
            xl = xl + g2 * peer(hl, peer_wq[i], peer_keys[i], peer_u[i], peer_v[i])
        else:
            xc = xc + cg1 * yc
            hc = rmsnorm(xc, norm2_g[i]) * (1.0 + cs2) + csh2
            f = peer(jnp.concatenate([hc, hl], axis=1), peer_wq[i], peer_keys[i], peer_u[i], peer_v[i])
            xc = xc + cg2 * f[:, :C]
            xl = xl + g2 * f[:, C:]
    return rmsnorm(xl, final_g)
```

```cpp
#include <hip/hip_runtime.h>
#include <cstdio>
#include <cstdint>
#include <cmath>

constexpr int D = 1024, NB = 4, SEQ = 8192, CTX = 256, DEPTH = 2;
constexpr int R_CTX = NB * CTX;
constexpr int R_LAT = NB * SEQ;
constexpr int R = R_CTX + R_LAT;
constexpr int D_IN = 2048, NMOD = 6 * D;
constexpr int C_CONVB = 0, C_CONVC = 256, C_CONVX = 512, C_SGUU = 768, C_SGUV = 1024, C_Q = 1280, C_K = 1792, C_V = 1920;
constexpr int NEXP = 16384;
constexpr float EPS = 1e-6f;

__device__ __forceinline__ int row_modb(int r) { return r < R_CTX ? 4 : ((r - R_CTX) >> 13); }
__device__ __forceinline__ int row_t(int r) { return r < R_CTX ? (r & 255) : ((r - R_CTX) & 8191); }
__device__ __forceinline__ int row_len(int r) { return r < R_CTX ? CTX : SEQ; }

__device__ __forceinline__ float wave_sum(float v) {
#pragma unroll
    for (int o = 1; o < 64; o <<= 1) v += __shfl_xor(v, o);
    return v;
}
__device__ __forceinline__ float wave_max(float v) {
#pragma unroll
    for (int o = 1; o < 64; o <<= 1) v = fmaxf(v, __shfl_xor(v, o));
    return v;
}
__device__ __forceinline__ float gelu_tanh(float x) {
    const float k = 0.7978845608028654f;
    return 0.5f * x * (1.0f + tanhf(k * (x + 0.044715f * x * x * x)));
}
__device__ __forceinline__ float silu(float x) { return x / (1.0f + expf(-x)); }

struct XPtr { float* xc; float* xl; };
__device__ __forceinline__ float* xrow(const XPtr& X, int r) { return r < R_CTX ? X.xc + (size_t)r * D : X.xl + (size_t)(r - R_CTX) * D; }

__global__ void __launch_bounds__(256) k_mods(const float* c, const float* c_ctx, const float* w_ada, const float* b_ada, float* mods) {
    __shared__ float sc[5][D];
    for (int i = threadIdx.x; i < 5 * D; i += 256) { const int b = i / D, k = i % D; sc[b][k] = silu(b < 4 ? c[b * D + k] : c_ctx[k]); }
    __syncthreads();
    const int layer = blockIdx.y, n = blockIdx.x * 256 + threadIdx.x;
    const float* W = w_ada + (size_t)layer * D * NMOD;
    float a0 = 0, a1 = 0, a2 = 0, a3 = 0, a4 = 0;
    for (int k = 0; k < D; ++k) { const float w = W[(size_t)k * NMOD + n]; a0 += sc[0][k] * w; a1 += sc[1][k] * w; a2 += sc[2][k] * w; a3 += sc[3][k] * w; a4 += sc[4][k] * w; }
    const float bb = b_ada[layer * NMOD + n];
    float* M = mods + (size_t)layer * 5 * NMOD;
    M[0 * NMOD + n] = a0 + bb; M[1 * NMOD + n] = a1 + bb; M[2 * NMOD + n] = a2 + bb; M[3 * NMOD + n] = a3 + bb; M[4 * NMOD + n] = a4 + bb;
}

__global__ void __launch_bounds__(256) k_normmod(XPtr X, const float* g, const float* modsL, int shift_idx, int scale_idx, float* H, int row_lo) {
    const int gw = blockIdx.x * 4 + (threadIdx.x >> 6), lane = threadIdx.x & 63;
    const int r = row_lo + gw; if (r >= R) return;
    const float* x = xrow(X, r); const int mb = row_modb(r);
    const float* sh = modsL + (size_t)mb * NMOD + shift_idx * D; const float* sc = modsL + (size_t)mb * NMOD + scale_idx * D;
    float v[16]; float ss = 0.f;
#pragma unroll
    for (int j = 0; j < 16; ++j) { v[j] = x[lane + 64 * j]; ss += v[j] * v[j]; }
    ss = wave_sum(ss); const float rs = rsqrtf(ss * (1.0f / D) + EPS);
#pragma unroll
    for (int j = 0; j < 16; ++j) { const int cidx = lane + 64 * j; H[(size_t)r * D + cidx] = v[j] * rs * g[cidx] * (1.0f + sc[cidx]) + sh[cidx]; }
}

template <int EPI>
__global__ void __launch_bounds__(256) k_gemm(const float* A, const float* B, float* C, int M, int N, int K, int row_lo, XPtr X, const float* modsL, int gate_idx) {
    __shared__ float As[16][65];
    __shared__ float Bs[16][64];
    const int tid = threadIdx.x, tx = tid & 15, ty = tid >> 4;
    const int m0 = row_lo + blockIdx.y * 64, n0 = blockIdx.x * 64;
    float acc[4][4] = {};
    for (int k0 = 0; k0 < K; k0 += 16) {
#pragma unroll
        for (int i = 0; i < 4; ++i) { const int e = tid + 256 * i, rr = e >> 4, kk = e & 15; As[kk][rr] = A[(size_t)(m0 + rr) * K + k0 + kk]; }
#pragma unroll
        for (int i = 0; i < 4; ++i) { const int e = tid + 256 * i, kk = e >> 6, cc = e & 63; Bs[kk][cc] = B[(size_t)(k0 + kk) * N + n0 + cc]; }
        __syncthreads();
#pragma unroll
        for (int kk = 0; kk < 16; ++kk) {
            float a[4], b[4];
#pragma unroll
            for (int i = 0; i < 4; ++i) { a[i] = As[kk][ty * 4 + i]; b[i] = Bs[kk][tx * 4 + i]; }
#pragma unroll
            for (int i = 0; i < 4; ++i)
#pragma unroll
                for (int j = 0; j < 4; ++j) acc[i][j] += a[i] * b[j];
        }
        __syncthreads();
    }
#pragma unroll
    for (int i = 0; i < 4; ++i) {
        const int r = m0 + ty * 4 + i;
#pragma unroll
        for (int j = 0; j < 4; ++j) {
            const int cidx = n0 + tx * 4 + j;
            if (EPI == 0) C[(size_t)r * N + cidx] = acc[i][j];
            else { float* xr = xrow(X, r); const float gt = modsL[(size_t)row_modb(r) * NMOD + gate_idx * D + cidx]; xr[cidx] += gt * acc[i][j]; }
        }
    }
}

__global__ void __launch_bounds__(256) k_conv(const float* P, const float* cw, float* Y, int row_lo) {
    const int r = row_lo + blockIdx.x, c = threadIdx.x;
    const int t = row_t(r), len = row_len(r);
    const float* p = P + (size_t)r * D_IN;
    const float z1 = p[C_CONVC + c] * p[C_CONVX + c];
    const float z0 = t > 0 ? p[-D_IN + C_CONVC + c] * p[-D_IN + C_CONVX + c] : 0.f;
    const float z2 = t < len - 1 ? p[D_IN + C_CONVC + c] * p[D_IN + C_CONVX + c] : 0.f;
    Y[(size_t)r * D + c] = p[C_CONVB + c] * (z0 * cw[c] + z1 * cw[256 + c] + z2 * cw[512 + c]);
}

__global__ void __launch_bounds__(256) k_sgu_ln(float* P, const float* gn, int row_lo) {
    const int gw = blockIdx.x * 4 + (threadIdx.x >> 6), lane = threadIdx.x & 63;
    const int r = row_lo + gw; if (r >= R) return;
    float* p = P + (size_t)r * D_IN;
    float u[4], v[4]; float s = 0.f;
#pragma unroll
    for (int j = 0; j < 4; ++j) { u[j] = gelu_tanh(p[C_SGUU + lane + 64 * j]); v[j] = gelu_tanh(p[C_SGUV + lane + 64 * j]); s += v[j]; }
    const float mu = wave_sum(s) * (1.0f / 256.0f); float q = 0.f;
#pragma unroll
    for (int j = 0; j < 4; ++j) { v[j] -= mu; q += v[j] * v[j]; }
    const float rs = rsqrtf(wave_sum(q) * (1.0f / 256.0f) + EPS);
#pragma unroll
    for (int j = 0; j < 4; ++j) { p[C_SGUU + lane + 64 * j] = u[j]; p[C_SGUV + lane + 64 * j] = v[j] * rs * gn[lane + 64 * j]; }
}
__global__ void __launch_bounds__(256) k_sgu_mix(const float* P, const float* ws_, const float* bs, float* Y, int row_lo) {
    const int r = row_lo + blockIdx.x, ch = threadIdx.x, h = ch >> 6;
    const int p = r & 127, r0 = r - p;
    const float* w = ws_ + ((size_t)h * 128 + p) * 128;
    float s = 0.f;
    for (int q = 0; q < 128; ++q) s += w[q] * P[(size_t)(r0 + q) * D_IN + C_SGUV + ch];
    s += bs[h * 128 + p];
    Y[(size_t)r * D + 256 + ch] = P[(size_t)r * D_IN + C_SGUU + ch] * s;
}

__global__ void __launch_bounds__(320) k_rope(float* P) {
    const int r = R_CTX + blockIdx.x, t = (r - R_CTX) & 8191;
    const int head = threadIdx.x >> 5, jj = threadIdx.x & 31;
    float* base = P + (size_t)r * D_IN + (head < 8 ? C_Q + head * 64 : C_K + (head - 8) * 64);
    const int j = jj & 15; const bool colhalf = jj >= 16;
    const float inv = powf(10000.0f, -(float)j / 16.0f);
    const float pos = colhalf ? (float)(t & 63) : (float)(t >> 6);
    const float ang = pos * inv; const float cs = cosf(ang), sn = sinf(ang);
    float* pa = base + (colhalf ? 32 : 0) + j; float* pb = pa + 16;
    const float a = *pa, b = *pb;
    *pa = a * cs - b * sn; *pb = b * cs + a * sn;
}

__global__ void __launch_bounds__(256) k_attn(const float* P, const float* sink, float* Y, int row_lo) {
    __shared__ float pbuf[4][576];
    const int wv = threadIdx.x >> 6, lane = threadIdx.x & 63;
    const int item = blockIdx.x * 4 + wv; const int r = row_lo + (item >> 3), head = item & 7, kvh = head >> 2;
    if (r >= R) return;
    const bool lat = r >= R_CTX; const int b = lat ? ((r - R_CTX) >> 13) : (r >> 8);
    const float* q = P + (size_t)r * D_IN + C_Q + head * 64;
    const int cbase = b * CTX;
    int lo = 0, nloc = 0;
    if (lat) { const int t = (r - R_CTX) & 8191; const int tlo = t - 128 < 0 ? 0 : t - 128, thi = t + 128 > SEQ - 1 ? SEQ - 1 : t + 128; lo = r - (t - tlo); nloc = thi - tlo + 1; }
    const int nk = CTX + nloc;
    float* pb = pbuf[wv];
    float mx = sink[head];
    for (int i = lane; i < nk; i += 64) {
        const int kr = i < CTX ? cbase + i : lo + (i - CTX);
        const float* kp = P + (size_t)kr * D_IN + C_K + kvh * 64;
        float s = 0.f;
        for (int d = 0; d < 64; ++d) s += q[d] * kp[d];
        s *= 0.125f; pb[i] = s; mx = fmaxf(mx, s);
    }
    mx = wave_max(mx);
    float den = 0.f;
    for (int i = lane; i < nk; i += 64) { const float e = expf(pb[i] - mx); pb[i] = e; den += e; }
    den = wave_sum(den) + expf(sink[head] - mx);
    __builtin_amdgcn_s_waitcnt(0);
    float o = 0.f;
    for (int i = 0; i < nk; ++i) { const int kr = i < CTX ? cbase + i : lo + (i - CTX); o += pb[i] * P[(size_t)kr * D_IN + C_V + kvh * 64 + lane]; }
    Y[(size_t)r * D + 512 + head * 64 + lane] = o / den;
}

__global__ void __launch_bounds__(256) k_mergenorm(float* Y, const float* g, int row_lo) {
    const int gw = blockIdx.x * 4 + (threadIdx.x >> 6), lane = threadIdx.x & 63;
    const int r = row_lo + gw; if (r >= R) return;
    float* y = Y + (size_t)r * D;
    float v[16]; float s0 = 0, s1 = 0, s2 = 0;
#pragma unroll
    for (int j = 0; j < 16; ++j) { v[j] = y[lane + 64 * j]; const float q = v[j] * v[j]; if (j < 4) s0 += q; else if (j < 8) s1 += q; else s2 += q; }
    s0 = wave_sum(s0); s1 = wave_sum(s1); s2 = wave_sum(s2);
    const float r0 = rsqrtf(s0 * (1.0f / 256.0f) + EPS), r1 = rsqrtf(s1 * (1.0f / 256.0f) + EPS), r2 = rsqrtf(s2 * (1.0f / 512.0f) + EPS);
#pragma unroll
    for (int j = 0; j < 16; ++j) { const float rr = j < 4 ? r0 : (j < 8 ? r1 : r2); y[lane + 64 * j] = v[j] * rr * g[lane + 64 * j]; }
}

__global__ void __launch_bounds__(256) k_topk(const float* QP, const float* keys, int* eidx, float* egate, int row_lo) {
    __shared__ float qs[256]; __shared__ float sc[256]; __shared__ float sv[2][16]; __shared__ int si[2][16]; __shared__ float cand[256]; __shared__ float fv[16]; __shared__ int fe[16];
    const int r = row_lo + blockIdx.x, h = blockIdx.y, tid = threadIdx.x, p = tid >> 7, k = tid & 127;
    qs[tid] = QP[(size_t)r * 2048 + h * 256 + tid];
    __syncthreads();
    { const float* kp = keys + (((size_t)h * 2 + p) * 128 + k) * 128; float s = 0.f; for (int d = 0; d < 128; ++d) s += qs[p * 128 + d] * kp[d]; sc[tid] = s; }
    __syncthreads();
    { const float my = sc[tid]; int rank = 0; for (int j = 0; j < 128; ++j) { const float o = sc[p * 128 + j]; rank += (o > my || (o == my && j < k)) ? 1 : 0; } if (rank < 16) { sv[p][rank] = my; si[p][rank] = k; } }
    __syncthreads();
    { const int a = tid >> 4, bq = tid & 15; cand[tid] = sv[0][a] + sv[1][bq]; }
    __syncthreads();
    { const float my = cand[tid]; int rank = 0; for (int j = 0; j < 256; ++j) { const float o = cand[j]; rank += (o > my || (o == my && j < tid)) ? 1 : 0; }
      if (rank < 16) { fv[rank] = my; fe[rank] = si[0][tid >> 4] * 128 + si[1][tid & 15]; } }
    __syncthreads();
    if (tid < 16) { const float m = fv[0]; float den = 0.f; for (int j = 0; j < 16; ++j) den += expf(fv[j] - m);
        eidx[(size_t)r * 128 + h * 16 + tid] = fe[tid]; egate[(size_t)r * 128 + h * 16 + tid] = expf(fv[tid] - m) / den; }
}

__global__ void __launch_bounds__(256) k_peer(const float* H, const float* U, const float* V, const int* eidx, const float* egate, XPtr X, const float* modsL, int row_lo) {
    const int gw = blockIdx.x * 4 + (threadIdx.x >> 6), lane = threadIdx.x & 63;
    const int r = row_lo + gw; if (r >= R) return;
    float h[16], o[16];
#pragma unroll
    for (int j = 0; j < 16; ++j) { h[j] = H[(size_t)r * D + lane + 64 * j]; o[j] = 0.f; }
    for (int k = 0; k < 128; ++k) {
        const int e = eidx[(size_t)r * 128 + k]; const float gt = egate[(size_t)r * 128 + k];
        const float* u = U + (size_t)e * D; const float* v = V + (size_t)e * D;
        float s = 0.f;
#pragma unroll
        for (int j = 0; j < 16; ++j) s += u[lane + 64 * j] * h[j];
        s = wave_sum(s);
        const float a = gelu_tanh(s) * gt;
#pragma unroll
        for (int j = 0; j < 16; ++j) o[j] += a * v[lane + 64 * j];
    }
    float* x = xrow(X, r); const float* g2 = modsL + (size_t)row_modb(r) * NMOD + 5 * D;
#pragma unroll
    for (int j = 0; j < 16; ++j) x[lane + 64 * j] += g2[lane + 64 * j] * o[j];
}

__global__ void __launch_bounds__(256) k_final(float* out, const float* g) {
    const int gw = blockIdx.x * 4 + (threadIdx.x >> 6), lane = threadIdx.x & 63;
    float* x = out + (size_t)gw * D;
    float v[16]; float ss = 0.f;
#pragma unroll
    for (int j = 0; j < 16; ++j) { v[j] = x[lane + 64 * j]; ss += v[j] * v[j]; }
    const float rs = rsqrtf(wave_sum(ss) * (1.0f / D) + EPS);
#pragma unroll
    for (int j = 0; j < 16; ++j) x[lane + 64 * j] = v[j] * rs * g[lane + 64 * j];
}

extern "C" void kernel_launch(void* const* d_in, const int* in_sizes, int n_in, void* d_out, int out_size, void* d_ws, size_t ws_size, hipStream_t stream) {
    const float* x = (const float*)d_in[0]; const float* c = (const float*)d_in[1]; const float* ctx = (const float*)d_in[2]; const float* c_ctx = (const float*)d_in[3];
    const float* w_ada = (const float*)d_in[4]; const float* b_ada = (const float*)d_in[5]; const float* norm1_g = (const float*)d_in[6]; const float* norm2_g = (const float*)d_in[7];
    const float* w_in = (const float*)d_in[8]; const float* conv_w = (const float*)d_in[9]; const float* sgu_norm_g = (const float*)d_in[10]; const float* sgu_w = (const float*)d_in[11];
    const float* sgu_b = (const float*)d_in[12]; const float* attn_sink = (const float*)d_in[13]; const float* mix_norm_g = (const float*)d_in[14]; const float* w_out = (const float*)d_in[15];
    const float* peer_wq = (const float*)d_in[16]; const float* peer_keys = (const float*)d_in[17]; const float* peer_u = (const float*)d_in[18]; const float* peer_v = (const float*)d_in[19];
    const float* final_g = (const float*)d_in[20];
    char* ws = (char*)d_ws; size_t off = 0;
    auto carve = [&](size_t bytes) { char* p = ws + off; off += (bytes + 255) & ~(size_t)255; return p; };
    float* mods = (float*)carve((size_t)DEPTH * 5 * NMOD * 4);
    float* Xc = (float*)carve((size_t)R_CTX * D * 4);
    float* H = (float*)carve((size_t)R * D * 4);
    float* P = (float*)carve((size_t)R * D_IN * 4);
    int* eidx = (int*)carve((size_t)R * 128 * 4);
    float* egate = (float*)carve((size_t)R * 128 * 4);
    if (off > ws_size) { fprintf(stderr, "ws too small: need %zu have %zu\n", off, ws_size); return; }
    float* Xl = (float*)d_out;
    XPtr X{Xc, Xl};
    hipMemcpyAsync(Xl, x, (size_t)R_LAT * D * 4, hipMemcpyDeviceToDevice, stream);
    hipMemcpyAsync(Xc, ctx, (size_t)R_CTX * D * 4, hipMemcpyDeviceToDevice, stream);
    k_mods<<<dim3(NMOD / 256, DEPTH), 256, 0, stream>>>(c, c_ctx, w_ada, b_ada, mods);
    for (int i = 0; i < DEPTH; ++i) {
        const bool last = (i == DEPTH - 1);
        const float* modsL = mods + (size_t)i * 5 * NMOD;
        const int rlo = 0;
        const int rlo2 = last ? R_CTX : 0;
        const int nr = R - rlo, nr2 = R - rlo2;
        k_normmod<<<(nr + 3) / 4, 256, 0, stream>>>(X, norm1_g + i * D, modsL, 0, 1, H, rlo);
        k_gemm<0><<<dim3(D_IN / 64, nr / 64), 256, 0, stream>>>(H, w_in + (size_t)i * D * D_IN, P, R, D_IN, D, rlo, X, modsL, 0);
        float* Y = H;
        k_conv<<<nr2, 256, 0, stream>>>(P, conv_w + i * 3 * 256, Y, rlo2);
        k_sgu_ln<<<(nr2 + 3) / 4, 256, 0, stream>>>(P, sgu_norm_g + i * 256, rlo2);
        k_sgu_mix<<<nr2, 256, 0, stream>>>(P, sgu_w + (size_t)i * 4 * 128 * 128, sgu_b + i * 4 * 128, Y, rlo2);
        k_rope<<<R_LAT, 320, 0, stream>>>(P);
        k_attn<<<(nr2 * 8 + 3) / 4, 256, 0, stream>>>(P, attn_sink + i * 8, Y, rlo2);
        k_mergenorm<<<(nr2 + 3) / 4, 256, 0, stream>>>(Y, mix_norm_g + i * D, rlo2);
        k_gemm<1><<<dim3(D / 64, nr2 / 64), 256, 0, stream>>>(Y, w_out + (size_t)i * D * D, nullptr, R, D, D, rlo2, X, modsL, 2);
        k_normmod<<<(nr2 + 3) / 4, 256, 0, stream>>>(X, norm2_g + i * D, modsL, 3, 4, H, rlo2);
        k_gemm<0><<<dim3(2048 / 64, nr2 / 64), 256, 0, stream>>>(H, peer_wq + (size_t)i * D * 2048, P, R, 2048, D, rlo2, X, modsL, 0);
        k_topk<<<dim3(nr2, 8), 256, 0, stream>>>(P, peer_keys + (size_t)i * 8 * 2 * 128 * 128, eidx, egate, rlo2);
        k_peer<<<(nr2 + 3) / 4, 256, 0, stream>>>(H, peer_u + (size_t)i * NEXP * D, peer_v + (size_t)i * NEXP * D, eidx, egate, X, modsL, rlo2);
    }
    k_final<<<R_LAT / 4, 256, 0, stream>>>(Xl, final_g);
}
```

```cpp
#include <hip/hip_runtime.h>
#include <cstdio>
#include <cstdint>
#include <cmath>
namespace pg8 {
#define PG8_LAS __attribute__((address_space(3)))
typedef unsigned short bf16_t;
typedef short bf16x8 __attribute__((ext_vector_type(8)));
typedef float f32x4 __attribute__((ext_vector_type(4)));
typedef unsigned u32x4 __attribute__((ext_vector_type(4)));
constexpr int BM = 256, BK = 64, HALF = 128, HTB = HALF * BK * 2  , STAGE_BYTES = 8 * HTB, NXCD = 8, WGM = 8;

__host__ __device__ __forceinline__ int lds_byte(int r, int c) { const int st = (r >> 4) * 2 + (c >> 5), rr = r & 15, cc = c & 31, ob = rr * 64 + cc * 2; return st * 1024 + (ob ^ (((ob >> 9) & 1) << 5)); }
__host__ __device__ __forceinline__ void stage_rc(int b, int& R, int& C) { const int st = b / 1024, sb = b % 1024, swz = sb ^ (((sb >> 9) & 1) << 5); R = (st >> 1) * 16 + swz / 64; C = (st & 1) * 32 + (swz % 64) / 2; }
__host__ __device__ __forceinline__ int perm32(int rho) { const int n = rho >> 4, i = rho & 15; return 8 * (i >> 2) + 4 * n + (i & 3); }

struct Unit { int pm, pn; };
struct Gemm { const bf16_t* A; const bf16_t* Bt; int M, N, K; };

struct StaticOrder {
    int nM, nN, nwg, G, c;
    __host__ __device__ void init(int M, int N, int G_, int c_) { nM = M / BM; nN = N / BM; nwg = nM * nN; G = G_; c = c_; }
    __host__ __device__ bool next(int i, Unit& u) const {
        const long L = (long)i * G + c; if (L >= nwg) return false;
        int wgid = (int)L; { const int q = nwg / NXCD, r = nwg % NXCD, xcd = wgid % NXCD, off = wgid / NXCD; wgid = (xcd < r ? xcd * (q + 1) : r * (q + 1) + (xcd - r) * q) + off; }
        const int nig = WGM * nN, gid = wgid / nig, fm = gid * WGM, gsz = (nM - fm) < WGM ? (nM - fm) : WGM;
        u.pm = fm + ((wgid % nig) % gsz); u.pn = (wgid % nig) / gsz; return true;
    }
    __device__ __forceinline__ void a_ready(const Unit&) const {}
    __device__ __forceinline__ void done(const Unit&) const {}
};

__device__ __forceinline__ unsigned cvt_pk_bf16(float lo, float hi) { unsigned r; asm volatile("v_cvt_pk_bf16_f32 %0, %1, %2" : "=v"(r) : "v"(lo), "v"(hi)); return r; }
typedef float f32x2 __attribute__((ext_vector_type(2)));
__device__ __forceinline__ f32x2 gelu_pk(f32x2 v) {
    const f32x2 av = __builtin_elementwise_abs(v), d = av * 0.2316418882f + 1.0f;
    f32x2 t; t.x = __builtin_amdgcn_rcpf(d.x); t.y = __builtin_amdgcn_rcpf(d.y);
    f32x2 q = t * 0.5307027145f + (-0.7265760135f); q = q * t + 0.7107068705f; q = q * t + (-0.142248368f); q = q * t + 0.127414796f; q = q * t;
    const f32x2 s = (v * v) * (-0.72134752044f);
    f32x2 e; e.x = __builtin_amdgcn_exp2f(s.x); e.y = __builtin_amdgcn_exp2f(s.y);
    const f32x2 m = v * (q * e), r = v - m;
    f32x2 o; o.x = v.x < 0.f ? m.x : r.x; o.y = v.y < 0.f ? m.y : r.y; return o;
}

template <int ACT  > struct EpiBf16 {
    static constexpr bool PERM = true, AFTER_DRAIN = false, HAS_MID = false; static_assert(ACT == 0 || ACT == 1, "EpiBf16: ACT is 0 (none) or 1 (gelu_pk)");
    bf16_t* O; int ldc; const float* bias; int split_cols; size_t split_stride; float scale0; int rpm = BM, nai = 2;
    __device__ __forceinline__ void operator()(const f32x4 (&acc)[2][2][4][2], const Unit& u, int wr, int wc, int fr, int fq) const {
        const int row0 = u.pm * rpm + wr * 64 + fr; int colt = u.pn * BM; bf16_t* base = O;
        float sc = 1.f; if (split_cols) { const int t = colt / split_cols; base += (size_t)t * split_stride; colt -= t * split_cols; if (t == 0) sc = scale0; }
        const int col0 = colt + wc * 32 + 8 * fq, bcol0 = u.pn * BM + wc * 32 + 8 * fq;
        f32x4 bv[2][2];
#pragma unroll
        for (int bj = 0; bj < 2; ++bj)
#pragma unroll
            for (int n = 0; n < 2; ++n) bv[bj][n] = bias ? *(const f32x4*)(bias + bcol0 + bj * HALF + 4 * n) : (f32x4){0.f, 0.f, 0.f, 0.f};
#pragma unroll
        for (int ai = 0; ai < 2; ++ai) if (ai < nai)
#pragma unroll
            for (int m = 0; m < 4; ++m) { bf16_t* rowp = base + (size_t)(row0 + ai * HALF + m * 16) * ldc + col0;
#pragma unroll
                for (int bj = 0; bj < 2; ++bj) { f32x4 v0 = acc[ai][bj][m][0] + bv[bj][0], v1 = acc[ai][bj][m][1] + bv[bj][1];
                    if (ACT == 1) { f32x2 a = gelu_pk((f32x2){v0[0], v0[1]}), b = gelu_pk((f32x2){v0[2], v0[3]}), c = gelu_pk((f32x2){v1[0], v1[1]}), d = gelu_pk((f32x2){v1[2], v1[3]});
                        v0 = (f32x4){a.x, a.y, b.x, b.y}; v1 = (f32x4){c.x, c.y, d.x, d.y}; }
                    v0 = v0 * sc; v1 = v1 * sc; u32x4 w; w.x = cvt_pk_bf16(v0[0], v0[1]); w.y = cvt_pk_bf16(v0[2], v0[3]); w.z = cvt_pk_bf16(v1[0], v1[1]); w.w = cvt_pk_bf16(v1[2], v1[3]);
                    *(u32x4*)(rowp + bj * HALF) = w; } }
    }
};
template <bool BASE_F32> struct EpiResid {
    static constexpr bool PERM = true, AFTER_DRAIN = false, HAS_MID = true;
    const float* base_c; const float* base_l;
    bf16_t* X;
    const float* gate;
    const float* ssq;
    PG8_LAS float* tab;
    int row_off; int rpm = BM, nai = 2;
    __device__ __forceinline__ void pre(const Unit& u, int wr, int wc, int fr, int fq) const {
        const int lane = fq * 16 + fr; PG8_LAS float* tw = tab + (wr * 4 + wc) * 128;
#pragma unroll
        for (int ai = 0; ai < 2; ++ai) { const int r = row_off + u.pm * rpm + ai * HALF + wr * 64 + lane;
            const f32x4 s0 = *(const f32x4*)(ssq + (size_t)r * 8), s1 = *(const f32x4*)(ssq + (size_t)r * 8 + 4);
            tw[ai * 64 + lane] = sqrtf(((s0[0] + s0[1]) + (s0[2] + s0[3]) + (s1[0] + s1[1]) + (s1[2] + s1[3])) * (1.0f / 512.0f) + 1e-6f); }
        asm volatile("s_waitcnt lgkmcnt(0)" ::: "memory");
    }
    __device__ __forceinline__ void mid(f32x4 (&acc)[2][2][4][2], const Unit& u, int wr, int wc, int fr, int fq) const {
        const PG8_LAS float* tw = tab + (wr * 4 + wc) * 128;
#pragma unroll
        for (int ai = 0; ai < 2; ++ai)
#pragma unroll
            for (int m = 0; m < 4; ++m) { const float inv = tw[ai * 64 + m * 16 + fr];
#pragma unroll
                for (int bj = 0; bj < 2; ++bj)
#pragma unroll
                    for (int n = 0; n < 2; ++n) acc[ai][bj][m][n] *= inv; }
    }
    __device__ __forceinline__ void operator()(const f32x4 (&acc)[2][2][4][2], const Unit& u, int wr, int wc, int fr, int fq) const {
        const int rt = row_off + u.pm * rpm;
        const bool isc = rt < 1024; const int mb = isc ? 4 : ((rt - 1024) >> 13);
        const int col0 = u.pn * BM + wc * 32 + 8 * fq; const PG8_LAS float* tw = tab + (wr * 4 + wc) * 128;
        const float* gp = gate + (size_t)mb * 6144 + col0;
        const float* srcf = isc ? base_c + (size_t)rt * 1024 : base_l + (size_t)(rt - 1024) * 1024;
        f32x4 gq[2][2];
#pragma unroll
        for (int bj = 0; bj < 2; ++bj) { gq[bj][0] = *(const f32x4*)(gp + bj * HALF); gq[bj][1] = *(const f32x4*)(gp + bj * HALF + 4); }
        constexpr int MB_ = BASE_F32 ? 2 : 4, NBATCH = 8 / MB_;
#pragma unroll
        for (int ab = 0; ab < NBATCH; ++ab) { const int ai = (ab * MB_) >> 2, m0 = (ab * MB_) & 3; if (ai < nai) {
            f32x4 bf[MB_][2][2]; u32x4 bw[MB_][2];
#pragma unroll
            for (int mm = 0; mm < MB_; ++mm) { const int rl = ai * HALF + wr * 64 + (m0 + mm) * 16 + fr;
#pragma unroll
                for (int bj = 0; bj < 2; ++bj) {
                    if (BASE_F32) { bf[mm][bj][0] = *(const f32x4*)(srcf + (size_t)rl * 1024 + col0 + bj * HALF); bf[mm][bj][1] = *(const f32x4*)(srcf + (size_t)rl * 1024 + col0 + bj * HALF + 4); }
                    else bw[mm][bj] = *(const u32x4*)(X + (size_t)(rt + rl) * 1024 + col0 + bj * HALF); } }
#pragma unroll
            for (int mm = 0; mm < MB_; ++mm) { const int m = m0 + mm; const int rl = ai * HALF + wr * 64 + m * 16 + fr; const float rr = 1.0f / tw[ai * 64 + m * 16 + fr];
#pragma unroll
                for (int bj = 0; bj < 2; ++bj) { f32x4 b0, b1;
                    if (BASE_F32) { b0 = bf[mm][bj][0]; b1 = bf[mm][bj][1]; }
                    else { const u32x4 w = bw[mm][bj];
                        b0 = (f32x4){__builtin_bit_cast(float, w.x << 16), __builtin_bit_cast(float, w.x & 0xffff0000u), __builtin_bit_cast(float, w.y << 16), __builtin_bit_cast(float, w.y & 0xffff0000u)};
                        b1 = (f32x4){__builtin_bit_cast(float, w.z << 16), __builtin_bit_cast(float, w.z & 0xffff0000u), __builtin_bit_cast(float, w.w << 16), __builtin_bit_cast(float, w.w & 0xffff0000u)}; }
                    const f32x4 v0 = b0 + gq[bj][0] * (acc[ai][bj][m][0] * rr), v1 = b1 + gq[bj][1] * (acc[ai][bj][m][1] * rr);
                    u32x4 w; w.x = cvt_pk_bf16(v0[0], v0[1]); w.y = cvt_pk_bf16(v0[2], v0[3]); w.z = cvt_pk_bf16(v1[0], v1[1]); w.w = cvt_pk_bf16(v1[2], v1[3]);
                    *(u32x4*)(X + (size_t)(rt + rl) * 1024 + col0 + bj * HALF) = w; } }
            asm volatile("" ::: "memory"); } }
    }
};
struct OrderHalf {
    int nph, nN, pn0, G, c;
    __host__ __device__ void init(int nph_, int nN_, int pn0_, int G_, int c_) { nph = nph_; nN = nN_; pn0 = pn0_; G = G_; c = c_; }
    __host__ __device__ bool next(int i, Unit& u) const { const long L = (long)i * G + c; if (L >= (long)nph * nN) return false; u.pm = (int)(L % nph); u.pn = pn0 + (int)(L / nph); return true; }
    __device__ __forceinline__ void a_ready(const Unit&) const {}
    __device__ __forceinline__ void done(const Unit&) const {}
};
struct OrderLast {
    StaticOrder S; int G, c;
    __host__ __device__ void init(int G_, int c_) { S.init(32768, 2048, G_, c_); G = G_; c = c_; }
    __host__ __device__ bool next(int i, Unit& u) const {
        const long L = (long)i * G + c;
        if (L < 1024) { const bool ok = S.next(i, u); u.pm += 4; return ok; }
        if (L < 1028) { u.pm = (int)(L - 1024); u.pn = 7; return true; }
        return false;
    }
    __device__ __forceinline__ void a_ready(const Unit&) const {}
    __device__ __forceinline__ void done(const Unit&) const {}
};
template <class Epi, class Sched, bool ALIGN_EPI = false, bool SP2 = false, bool HALFM = false>
__device__ __forceinline__ void gemm_phase(PG8_LAS unsigned char* lds, const Gemm g, const Sched& S, const Epi& E, int tid_in) {
    int tid_l = tid_in; asm volatile("" : "+v"(tid_l));
    const int tid = tid_l, wid = __builtin_amdgcn_readfirstlane(tid >> 6), lane = tid & 63, wr = wid >> 2, wc = wid & 3, fr = lane & 15, fq = lane >> 4;
    const int K = g.K, nt = K / BK;
    unsigned voffA[2], voffB[2];
#pragma unroll
    for (int i = 0; i < 2; ++i) { int R, C; stage_rc(tid * 16 + i * 8192, R, C); const int Rb = Epi::PERM ? ((R & ~31) + perm32(R & 31)) : R;
        voffA[i] = (unsigned)(R * K + C) * 2u; voffB[i] = (unsigned)(Rb * K + C) * 2u; }
    const size_t kstep = (size_t)(BK * 2);
    const size_t hstep = (size_t)HALF * K * 2;
    const size_t tstep = 2 * hstep;
    const unsigned ldsw = (unsigned)wid * 1024u;
    const int aoff = lds_byte(wr * 64 + fr, fq * 8), boff = lds_byte(wc * 32 + fr, fq * 8);
#define PG8_SA(b, h) (((b) * 2 + (h)) * HTB)
#define PG8_SB(b, h) ((4 + (b) * 2 + (h)) * HTB)
#define PG8_STAGE(bufoff, gbase, voff) do { _Pragma("unroll") for (int _i = 0; _i < 2; ++_i) \
        __builtin_amdgcn_global_load_lds((const unsigned*)((const char*)(gbase) + (voff)[_i]), (PG8_LAS unsigned*)(lds + (bufoff) + ldsw + _i * 8192), 16, 0, 0); } while (0)
#define PG8_LDA(dst, b, h) do { _Pragma("unroll") for (int m = 0; m < 4; ++m) _Pragma("unroll") for (int k = 0; k < 2; ++k) dst[m][k] = *(const PG8_LAS bf16x8*)(lds + PG8_SA(b, h) + aoff + m * 2048 + k * 1024); } while (0)
#define PG8_LDB(dst, b, h) do { _Pragma("unroll") for (int n = 0; n < 2; ++n) _Pragma("unroll") for (int k = 0; k < 2; ++k) dst[n][k] = *(const PG8_LAS bf16x8*)(lds + PG8_SB(b, h) + boff + n * 2048 + k * 1024); } while (0)
#define PG8_MMA(ai, bj, At, Bt) do { __builtin_amdgcn_s_setprio(1); _Pragma("unroll") for (int m = 0; m < 4; ++m) _Pragma("unroll") for (int n = 0; n < 2; ++n) _Pragma("unroll") for (int k = 0; k < 2; ++k) \
        acc[ai][bj][m][n] = __builtin_amdgcn_mfma_f32_16x16x32_bf16(Bt[n][k], At[m][k], acc[ai][bj][m][n], 0, 0, 0); __builtin_amdgcn_s_setprio(0); } while (0)
#define PG8_WAIT_V(n) asm volatile("s_waitcnt vmcnt(" #n ")" ::: "memory")
#define PG8_WAIT_L(n) asm volatile("s_waitcnt lgkmcnt(" #n ")" ::: "memory")
#define PG8_BAR __builtin_amdgcn_s_barrier()
#define PG8_SCHED __builtin_amdgcn_sched_barrier(0)
    Unit cur, nxt; int ui = 0;
    if (!S.next(0, cur)) return;
    f32x4 acc[2][2][4][2];
#pragma unroll
    for (int a = 0; a < 2; ++a)
#pragma unroll
        for (int b = 0; b < 2; ++b)
#pragma unroll
            for (int m = 0; m < 4; ++m)
#pragma unroll
                for (int n = 0; n < 2; ++n) acc[a][b][m][n] = (f32x4){0.f, 0.f, 0.f, 0.f};
    bf16x8 At[4][2], B0[2][2], B1[2][2];
    const size_t astep = HALFM ? hstep : tstep;
    const char* cA = (const char*)g.A + (size_t)cur.pm * astep; const char* cB = (const char*)g.Bt + (size_t)cur.pn * tstep;
    S.a_ready(cur);
    if constexpr (Epi::HAS_MID) E.pre(cur, wr, wc, fr, fq);
    if constexpr (SP2) {
        PG8_STAGE(PG8_SB(0, 0), cB, voffB); PG8_STAGE(PG8_SB(0, 1), cB + hstep, voffB); PG8_STAGE(PG8_SA(0, 0), cA, voffA); PG8_STAGE(PG8_SA(0, 1), cA + hstep, voffA);
        if (wr == 1) PG8_BAR;
        PG8_WAIT_V(2); PG8_BAR;
        PG8_STAGE(PG8_SB(1, 0), cB + kstep, voffB); PG8_STAGE(PG8_SA(1, 0), cA + kstep, voffA); PG8_STAGE(PG8_SB(1, 1), cB + hstep + kstep, voffB);
        PG8_WAIT_V(6); PG8_BAR;
    } else {
        PG8_STAGE(PG8_SB(0, 0), cB, voffB); PG8_STAGE(PG8_SA(0, 0), cA, voffA); PG8_STAGE(PG8_SB(0, 1), cB + hstep, voffB); PG8_STAGE(PG8_SA(0, 1), cA + hstep, voffA);
        if (wr == 1) PG8_BAR;
        PG8_WAIT_V(4); PG8_BAR;
        PG8_STAGE(PG8_SB(1, 0), cB + kstep, voffB); PG8_STAGE(PG8_SA(1, 0), cA + kstep, voffA); PG8_STAGE(PG8_SB(1, 1), cB + hstep + kstep, voffB);
        PG8_WAIT_V(6); PG8_BAR;
    }
    for (;;) {
        const bool has_next = S.next(ui + 1, nxt);
        const char* nA = has_next ? (const char*)g.A + (size_t)nxt.pm * astep : cA; const char* nB = has_next ? (const char*)g.Bt + (size_t)nxt.pn * tstep : cB;
        for (int t = 0; t < nt; t += 2) {
            if constexpr (Epi::HAS_MID) { if (t == nt / 2) E.mid(acc, cur, wr, wc, fr, fq); }
            const bool last = (t == nt - 2);
            const char* a1 = cA + (size_t)(t + 1) * kstep;
            const char* a2 = last ? nA : cA + (size_t)(t + 2) * kstep; const char* b2 = last ? nB : cB + (size_t)(t + 2) * kstep;
            const char* a3 = a2 + kstep; const char* b3 = b2 + kstep;
            if (last && has_next) S.a_ready(nxt);
            if constexpr (SP2) {
            PG8_LDB(B0, 0, 0); PG8_LDB(B1, 0, 1); PG8_SCHED; PG8_LDA(At, 0, 0); PG8_STAGE(PG8_SA(1, 1), a1 + hstep, voffA);
            PG8_WAIT_V(8); PG8_WAIT_L(0); PG8_BAR; PG8_MMA(0, 0, At, B0); PG8_MMA(0, 1, At, B1); PG8_BAR; PG8_SCHED;
            PG8_LDA(At, 0, 1); PG8_STAGE(PG8_SB(0, 0), b2, voffB); PG8_STAGE(PG8_SB(0, 1), b2 + hstep, voffB); PG8_STAGE(PG8_SA(0, 0), a2, voffA);
            PG8_WAIT_V(8); PG8_WAIT_L(0); PG8_BAR; if constexpr (!HALFM) { PG8_MMA(1, 0, At, B0); PG8_MMA(1, 1, At, B1); } PG8_BAR; PG8_SCHED;
            PG8_LDB(B0, 1, 0); PG8_LDB(B1, 1, 1); PG8_SCHED; PG8_LDA(At, 1, 0); PG8_STAGE(PG8_SA(0, 1), a2 + hstep, voffA);
            PG8_WAIT_V(8); PG8_WAIT_L(0); PG8_BAR; PG8_MMA(0, 0, At, B0); PG8_MMA(0, 1, At, B1); PG8_BAR; PG8_SCHED;
            PG8_LDA(At, 1, 1); PG8_STAGE(PG8_SB(1, 0), b3, voffB); PG8_STAGE(PG8_SB(1, 1), b3 + hstep, voffB); PG8_STAGE(PG8_SA(1, 0), a3, voffA);
            PG8_WAIT_V(8); PG8_WAIT_L(0); PG8_BAR; if constexpr (!HALFM) { PG8_MMA(1, 0, At, B0); PG8_MMA(1, 1, At, B1); } PG8_BAR; PG8_SCHED;
            } else {
            PG8_LDB(B0, 0, 0); PG8_SCHED; PG8_LDA(At, 0, 0); PG8_STAGE(PG8_SA(1, 1), a1 + hstep, voffA);
            PG8_WAIT_L(8); PG8_BAR; PG8_WAIT_L(0); PG8_MMA(0, 0, At, B0); PG8_BAR; PG8_SCHED;
            PG8_LDB(B1, 0, 1); PG8_STAGE(PG8_SB(0, 0), b2, voffB);
            PG8_BAR; PG8_WAIT_L(0); PG8_MMA(0, 1, At, B1); PG8_BAR;
            PG8_LDA(At, 0, 1); PG8_STAGE(PG8_SA(0, 0), a2, voffA);
            PG8_BAR; PG8_WAIT_L(0); PG8_MMA(1, 0, At, B0); PG8_BAR; PG8_SCHED;
            PG8_STAGE(PG8_SB(0, 1), b2 + hstep, voffB);
            PG8_WAIT_V(6); PG8_BAR; PG8_MMA(1, 1, At, B1); PG8_BAR;
            PG8_LDB(B0, 1, 0); PG8_SCHED; PG8_LDA(At, 1, 0); PG8_STAGE(PG8_SA(0, 1), a2 + hstep, voffA);
            PG8_WAIT_L(8); PG8_BAR; PG8_WAIT_L(0); PG8_MMA(0, 0, At, B0); PG8_BAR; PG8_SCHED;
            PG8_LDB(B1, 1, 1); PG8_STAGE(PG8_SB(1, 0), b3, voffB);
            PG8_BAR; PG8_WAIT_L(0); PG8_MMA(0, 1, At, B1); PG8_BAR;
            PG8_LDA(At, 1, 1); PG8_STAGE(PG8_SA(1, 0), a3, voffA);
            PG8_BAR; PG8_WAIT_L(0); PG8_MMA(1, 0, At, B0); PG8_BAR; PG8_SCHED;
            PG8_STAGE(PG8_SB(1, 1), b3 + hstep, voffB);
            PG8_WAIT_V(6); PG8_BAR; PG8_MMA(1, 1, At, B1); PG8_BAR;
            }
        }
        if constexpr (ALIGN_EPI) { if (wr == 0) PG8_BAR; }
        if constexpr (!Epi::AFTER_DRAIN) { E(acc, cur, wr, wc, fr, fq); S.done(cur); }
        if (!has_next) break;
#pragma unroll
        for (int a = 0; a < 2; ++a)
#pragma unroll
            for (int b = 0; b < 2; ++b)
#pragma unroll
                for (int m = 0; m < 4; ++m)
#pragma unroll
                    for (int n = 0; n < 2; ++n) acc[a][b][m][n] = (f32x4){0.f, 0.f, 0.f, 0.f};
        cur = nxt; cA = nA; cB = nB; ++ui;
        if constexpr (Epi::HAS_MID) E.pre(cur, wr, wc, fr, fq);
        if constexpr (ALIGN_EPI) { if (wr == 1) PG8_BAR; }
    }
    PG8_WAIT_V(0);
    if constexpr (!ALIGN_EPI) { if (wr == 0) PG8_BAR; }
    PG8_BAR;
    if constexpr (Epi::AFTER_DRAIN) { E.fused(acc, cur, wr, wc, fr, fq, lds, wid, lane); S.done(cur); }
#undef PG8_SA
#undef PG8_SB
#undef PG8_STAGE
#undef PG8_LDA
#undef PG8_LDB
#undef PG8_MMA
#undef PG8_WAIT_V
#undef PG8_WAIT_L
#undef PG8_BAR
#undef PG8_SCHED
}
}
#define GAS __attribute__((address_space(1)))
#define LAS __attribute__((address_space(3)))
typedef unsigned short bf16;
typedef unsigned v4u __attribute__((ext_vector_type(4)));
typedef float f32x4 __attribute__((ext_vector_type(4)));
typedef short bf16x8 __attribute__((ext_vector_type(8)));
typedef GAS unsigned gu32;
typedef GAS unsigned long long gu64;
#define RLX_AGENT __ATOMIC_RELAXED, __HIP_MEMORY_SCOPE_AGENT
#define LDS_WAIT() asm volatile("s_waitcnt lgkmcnt(0)" ::: "memory")
#define VM_WAIT() asm volatile("s_waitcnt vmcnt(0)" ::: "memory")
__device__ __forceinline__ unsigned long long rt() { return __builtin_amdgcn_s_memrealtime(); }
__device__ __forceinline__ unsigned f2bf(float f) { unsigned u = __builtin_bit_cast(unsigned, f); return (u + 0x7fffu + ((u >> 16) & 1u)) >> 16; }
__device__ __forceinline__ unsigned pk2(float lo, float hi) { return f2bf(lo) | (f2bf(hi) << 16); }

#define XB_TMO      128
#define XB_XCNT(j)  (256  + 64 * (j))
#define XB_XSUB(j)  (1280 + 64 * (j))
#define XB_XGEN(j)  (2304 + 64 * (j))
#define XB_TOP      3328
#define XB_TOPGEN   3392
#define XCD_BAR_WORDS 3456
#define XB_SPIN_CAP (1u << 18)

__device__ __forceinline__ unsigned xb_ld(unsigned* p)              { return __hip_atomic_load(p, __ATOMIC_RELAXED, __HIP_MEMORY_SCOPE_AGENT); }
__device__ __forceinline__ unsigned xb_add(unsigned* p, unsigned v) { return __hip_atomic_fetch_add(p, v, __ATOMIC_RELAXED, __HIP_MEMORY_SCOPE_AGENT); }
__device__ __forceinline__ unsigned xb_xcc_id() { return (unsigned)__builtin_amdgcn_s_getreg((3 << 11) | 20) & 0xFu; }
#define XB_SPIN(cond, bar) do { unsigned _sp = 0; while (cond) { __builtin_amdgcn_s_sleep(1); \
    if ((++_sp & 255u) == 0u) { if (xb_ld(&(bar)[XB_TMO])) break; if (_sp > XB_SPIN_CAP) { atomicAdd(&(bar)[XB_TMO], 1u); break; } } } } while (0)

struct XcdBarrier {
    unsigned* bar; unsigned x;
    volatile LAS unsigned* st;
};

__device__ __forceinline__ XcdBarrier xcd_barrier_post(unsigned* bar, volatile LAS unsigned* st) {
    XcdBarrier b; b.bar = bar; b.x = xb_xcc_id(); b.st = st;
    if (threadIdx.x == 0) (void)xb_add(&bar[XB_XCNT(b.x)], 1u);
    return b;
}
__device__ __forceinline__ void xcd_barrier_complete(unsigned* bar, unsigned x, unsigned& nloc, unsigned& nx) {
    const unsigned G = gridDim.x * gridDim.y * gridDim.z;
    unsigned sum, cnt, mine, sp = 0u;
    for (;;) {
        sum = 0u; cnt = 0u; mine = 0u;
#pragma unroll
        for (unsigned j = 0; j < 16; ++j) { const unsigned c = xb_ld(&bar[XB_XCNT(j)]); sum += c; cnt += (c > 0u) ? 1u : 0u; mine = (j == x) ? c : mine; }
        if (sum == G) break;
        __builtin_amdgcn_s_sleep(1);
        if ((++sp & 255u) == 0u) { if (xb_ld(&bar[XB_TMO])) break; if (sp > XB_SPIN_CAP) { atomicAdd(&bar[XB_TMO], 1u); break; } }
    }
    nloc = mine > 0u ? mine : 1u; nx = cnt > 0u ? cnt : 1u;
}

__device__ __forceinline__ void xcd_barrier(const XcdBarrier& b, int tid_in) {
    asm volatile("s_waitcnt vmcnt(0)" ::: "memory");
    __syncthreads();
    if (tid_in == 0) {
        unsigned* bar = b.bar;
        __builtin_amdgcn_s_waitcnt(0);
        unsigned nloc = b.st[0], nx = b.st[1];
        if (nloc == 0u) { xcd_barrier_complete(bar, b.x, nloc, nx); b.st[0] = nloc; b.st[1] = nx; }
        const unsigned old = xb_add(&bar[XB_XSUB(b.x)], 1u);
        const unsigned gen = old / nloc;
        if (old + 1u == (gen + 1u) * nloc) {
            __builtin_amdgcn_fence(__ATOMIC_RELEASE, "agent");
            asm volatile("s_waitcnt vmcnt(0)" ::: "memory");
            const unsigned og = xb_add(&bar[XB_TOP], 1u);
            const unsigned tg = og / nx;
            if (og + 1u == (tg + 1u) * nx) xb_add(&bar[XB_TOPGEN], 1u);
            else XB_SPIN(xb_ld(&bar[XB_TOPGEN]) == tg, bar);
            __builtin_amdgcn_fence(__ATOMIC_ACQUIRE, "agent");
            xb_add(&bar[XB_XGEN(b.x)], 1u);
            asm volatile("s_waitcnt vmcnt(0)" ::: "memory");
        } else {
            XB_SPIN(xb_ld(&bar[XB_XGEN(b.x)]) == gen, bar);
            __builtin_amdgcn_fence(__ATOMIC_ACQUIRE, "agent");
            asm volatile("s_waitcnt vmcnt(0)" ::: "memory");
        }
    }
    __syncthreads();
}
constexpr int D = 1024, NB = 4, SEQ = 8192, CTXL = 256, DEPTH = 2;
constexpr int R_CTX = NB * CTXL, R_LAT = NB * SEQ, R = R_CTX + R_LAT;
constexpr int D_IN = 2048, NMOD = 6 * D, NEXP = 16384;
constexpr int C_CONVB = 0, C_CONVC = 256, C_CONVX = 512, C_SGUU = 768, C_SGUV = 1024, C_Q = 1280, C_K = 1792, C_V = 1920;
constexpr float EPS = 1e-6f;
constexpr float LOG2E = 1.4426950408889634f;
constexpr float QSCALE = 0.125f * LOG2E;
constexpr int NWAVES = 8;
constexpr size_t MiB = 1u << 20;
constexpr size_t WS_CTL = 0, CTL_ZERO_BYTES = 64 * 1024;
constexpr size_t WS_MODS = 1 * MiB, WS_ROPE = 1 * MiB + 256 * 1024, WS_SCALE = 1 * MiB + 512 * 1024;
constexpr size_t WS_WIN = 2 * MiB, WS_WOUT = 10 * MiB, WS_WQ = 14 * MiB, WS_TABU = 22 * MiB, WS_TABV = 54 * MiB, WS_X = 86 * MiB, WS_XN = 152 * MiB;
constexpr size_t WS_P = 218 * MiB, WS_Y = 350 * MiB, WS_Q = 416 * MiB, WS_K = 449 * MiB, WS_V = 458 * MiB, WS_SSQ = 467 * MiB, WS_EIDX = 469 * MiB, WS_GATE = 478 * MiB, WS_KEYS = 495 * MiB, WS_HSC = 496 * MiB, WS_CSUM = 496 * MiB + 512 * 1024, WS_COEF = 497 * MiB, WS_SGUW = 502 * MiB, WS_END = 503 * MiB;
constexpr size_t WS_H8 = WS_Y;
constexpr size_t WS_PART = WS_P;
constexpr int CW_RANK = 8192;
constexpr int CW_BAR = 1024;
constexpr int LDS_BYTES = 147456, MISC_OFF = 147456 - 512;

__device__ __forceinline__ int row_modb(int r) { return r < R_CTX ? 4 : ((r - R_CTX) >> 13); }
__device__ __forceinline__ int row_t(int r) { return r < R_CTX ? (r & 255) : ((r - R_CTX) & 8191); }
__device__ __forceinline__ float bf2f(unsigned short h) { return __builtin_bit_cast(float, (unsigned)h << 16); }
__device__ __forceinline__ float bflo(unsigned w) { return __builtin_bit_cast(float, w << 16); }
__device__ __forceinline__ float bfhi(unsigned w) { return __builtin_bit_cast(float, w & 0xffff0000u); }
__device__ __forceinline__ int lane_now() { int l; asm volatile("v_mbcnt_lo_u32_b32 %0, -1, 0\n\tv_mbcnt_hi_u32_b32 %0, -1, %0" : "=v"(l)); return l; }
__device__ __forceinline__ float shflx(float v, int m) { return __builtin_bit_cast(float, __builtin_amdgcn_ds_bpermute((lane_now() ^ m) << 2, __builtin_bit_cast(int, v))); }
__device__ __forceinline__ int shflx(int v, int m) { return __builtin_amdgcn_ds_bpermute((lane_now() ^ m) << 2, v); }
template <int CTRL> __device__ __forceinline__ int dpp_i(int v) { return __builtin_amdgcn_update_dpp(0, v, CTRL, 0xf, 0xf, true); }
template <int CTRL> __device__ __forceinline__ float dpp_f(float v) { return __builtin_bit_cast(float, __builtin_amdgcn_update_dpp(0, __builtin_bit_cast(int, v), CTRL, 0xf, 0xf, true)); }
struct OpSum { __device__ __forceinline__ float operator()(float a, float b) const { return a + b; } };
struct OpMax { __device__ __forceinline__ float operator()(float a, float b) const { return fmaxf(a, b); } };
template <class Op> __device__ __forceinline__ float red_row16(float v, Op op) { v = op(v, dpp_f<0xB1>(v)); v = op(v, dpp_f<0x4E>(v)); v = op(v, dpp_f<0x141>(v)); v = op(v, dpp_f<0x140>(v)); return v; }
template <class Op> __device__ __forceinline__ float red_x16(float v, Op op) { float a_ = v, b_ = v; asm volatile("s_nop 1\n\tv_permlane16_swap_b32 %0, %1" : "+v"(a_), "+v"(b_)); return op(a_, b_); }
template <class Op> __device__ __forceinline__ float red_x32(float v, Op op) { float a_ = v, b_ = v; asm volatile("s_nop 1\n\tv_permlane32_swap_b32 %0, %1" : "+v"(a_), "+v"(b_)); return op(a_, b_); }
__device__ __forceinline__ float wave_sum(float v) { return red_x32(red_x16(red_row16(v, OpSum()), OpSum()), OpSum()); }
__device__ __forceinline__ float wave_max(float v) { return red_x32(red_x16(red_row16(v, OpMax()), OpMax()), OpMax()); }
__device__ __forceinline__ float half_sum32(float v) { return red_x16(red_row16(v, OpSum()), OpSum()); }
__device__ __forceinline__ float gelu_tanh(float x) {
    const float y = 1.5957691216057308f * (x + 0.044715f * x * x * x);
    return x / (1.0f + __expf(-y));
}
__device__ __forceinline__ float silu(float x) { return x / (1.0f + __expf(-x)); }
__device__ __forceinline__ void unpack8(const v4u w, float (&f)[8]) { f[0] = bflo(w.x); f[1] = bfhi(w.x); f[2] = bflo(w.y); f[3] = bfhi(w.y); f[4] = bflo(w.z); f[5] = bfhi(w.z); f[6] = bflo(w.w); f[7] = bfhi(w.w); }
__device__ __forceinline__ v4u pack8(const float (&f)[8]) { v4u w; w.x = pk2(f[0], f[1]); w.y = pk2(f[2], f[3]); w.z = pk2(f[4], f[5]); w.w = pk2(f[6], f[7]); return w; }

struct Args { const float* in[21]; float* out; unsigned char* ws; int ph_lo, ph_hi; };
enum { I_X = 0, I_C, I_CTX, I_CCTX, I_WADA, I_BADA, I_N1G, I_N2G, I_WIN, I_CONVW, I_SGUG, I_SGUW, I_SGUB, I_SINK, I_MIXG, I_WOUT, I_WQ, I_KEYS, I_PU, I_PV, I_FING };

struct TItem { const float* W; bf16* WT; const float* ks; int N, k0, n0; };
__device__ __forceinline__ void titem_load(const TItem& t, int lane, float (&tv)[32]) {
#pragma unroll
    for (int i = 0; i < 32; ++i) tv[i] = t.W[(size_t)(t.k0 + 2 * i + (lane >> 5)) * t.N + t.n0 + (lane & 31)];
}
__device__ __forceinline__ void titem_finish(const TItem& t, int lane, const float (&tv)[32], LAS float* scr) {
#pragma unroll
    for (int i = 0; i < 32; ++i) { const int kk = 2 * i + (lane >> 5); float v = tv[i]; if (t.ks) v *= t.ks[t.k0 + kk]; scr[kk * 33 + (lane & 31)] = v; }
    LDS_WAIT(); asm volatile("" ::: "memory");
    const int c = lane & 7;
#pragma unroll
    for (int j = 0; j < 4; ++j) { const int n = (lane >> 3) + 8 * j; const LAS float* s = scr + (8 * c) * 33 + n;
        v4u o; o.x = pk2(s[0 * 33], s[1 * 33]); o.y = pk2(s[2 * 33], s[3 * 33]); o.z = pk2(s[4 * 33], s[5 * 33]); o.w = pk2(s[6 * 33], s[7 * 33]);
        *(GAS v4u*)(t.WT + (size_t)(t.n0 + n) * D + t.k0 + 8 * c) = o; }
    LDS_WAIT(); asm volatile("" ::: "memory");
}

__device__ __forceinline__ const float* table_src(const Args& a, int row, int lane) { const int t = row >> 14, e = row & (NEXP - 1); return ((t >> 1) ? a.in[I_PV] : a.in[I_PU]) + ((size_t)(t & 1) * NEXP + e) * D + 16 * lane; }
__device__ __forceinline__ void quant_store(unsigned char* ws, int row, int lane, const f32x4 (&v)[4]) {
    const int t = row >> 14, e = row & (NEXP - 1), layer = t & 1, isv = t >> 1;
    float mx = 0.f;
#pragma unroll
    for (int j = 0; j < 4; ++j) mx = fmaxf(mx, fmaxf(fmaxf(fabsf(v[j].x), fabsf(v[j].y)), fmaxf(fabsf(v[j].z), fabsf(v[j].w))));
    mx = wave_max(mx); mx = fmaxf(mx, 1e-30f);
    const float inv = 127.0f / mx;
    v4u o;
#pragma unroll
    for (int j = 0; j < 4; ++j) { unsigned w = 0;
#pragma unroll
        for (int i = 0; i < 4; ++i) { int q = (int)rintf(v[j][i] * inv); q = q < -127 ? -127 : (q > 127 ? 127 : q); w |= (unsigned)(q & 255) << (8 * i); }
        o[j] = w; }
    unsigned char* dst = ws + (isv ? WS_TABV : WS_TABU) + (size_t)layer * NEXP * D + (size_t)(lane >> 3) * (NEXP * 128) + (size_t)e * 128;
    *(GAS v4u*)(dst + (lane & 7) * 16) = o;
    if (lane == 0) ((float*)(ws + WS_SCALE))[(size_t)t * NEXP + e] = mx * (1.0f / 127.0f);
}
__device__ __forceinline__ void quant_rows(const Args& a, unsigned char* ws, int r0, int r1, int stride, int lane) {
    constexpr int QR = 7;
    for (int row = r0; row < r1; row += QR * stride) {
        f32x4 v[QR][4];
#pragma unroll
        for (int q = 0; q < QR; ++q) { const int rq = row + q * stride < r1 ? row + q * stride : row; const float* src = table_src(a, rq, lane);
#pragma unroll
            for (int j = 0; j < 4; ++j) v[q][j] = *(const f32x4*)(src + 4 * j); }
#pragma unroll
        for (int q = 0; q < QR; ++q) if (row + q * stride < r1) quant_store(ws, row + q * stride, lane, v[q]);
    }
}
__device__ __forceinline__ void tail_quant(const Args& a, unsigned char* ws, int k, int c, int G, int wave, int lane) {
    const int busy[3] = {64, 32, 64};
    int tot = 0, before = 0;
#pragma unroll
    for (int i = 0; i < 3; ++i) { const int idle = G > busy[i] ? G - busy[i] : 0; if (i < k) before += idle; tot += idle; }
    if (tot == 0) { if (k == 2) quant_rows(a, ws, c * NWAVES + wave, 4 * NEXP, G * NWAVES, lane); return; }
    if (c < busy[k]) return;
    const int per = (4 * NEXP + tot - 1) / tot, q = before + (c - busy[k]);
    const int r0 = q * per, r1 = (r0 + per < 4 * NEXP) ? r0 + per : 4 * NEXP;
    quant_rows(a, ws, r0 + wave, r1, NWAVES, lane);
}
__device__ __forceinline__ void ph_prologue(const Args& a, LAS unsigned char* L, int tid, int lane, int wave, int vcu, int G) {
    unsigned char* ws = a.ws;
    const int gw = vcu * NWAVES + wave, NGW = G * NWAVES;
    if (vcu < 192) {
        LAS float* sc = (LAS float*)L;
        LAS float* part = (LAS float*)(L + 20480);
        for (int i = tid; i < 5 * D; i += 512) { const int b = i >> 10, k = i & 1023; sc[i] = silu(b < 4 ? a.in[I_C][b * D + k] : a.in[I_CCTX][k]); }
        __syncthreads();
        for (int it = vcu; it < 192; it += G) {
            const int layer = it / 96, n = (it % 96) * 64 + lane;
            const float* W = a.in[I_WADA] + (size_t)layer * D * NMOD + n;
            float a0 = 0.f, a1 = 0.f, a2 = 0.f, a3 = 0.f, a4 = 0.f;
#pragma unroll 64
            for (int kk = 0; kk < 128; ++kk) { const int k = wave * 128 + kk; const float w = W[(size_t)k * NMOD];
                a0 += sc[k] * w; a1 += sc[1024 + k] * w; a2 += sc[2048 + k] * w; a3 += sc[3072 + k] * w; a4 += sc[4096 + k] * w; }
            part[(wave * 5 + 0) * 64 + lane] = a0; part[(wave * 5 + 1) * 64 + lane] = a1; part[(wave * 5 + 2) * 64 + lane] = a2; part[(wave * 5 + 3) * 64 + lane] = a3; part[(wave * 5 + 4) * 64 + lane] = a4;
            __syncthreads();
            if (tid < 320) { const int b = tid >> 6, l2 = tid & 63; float s = 0.f;
#pragma unroll
                for (int w = 0; w < 8; ++w) s += part[(w * 5 + b) * 64 + l2];
                const int nn = (it % 96) * 64 + l2;
                ((float*)(ws + WS_MODS))[((size_t)layer * 5 + b) * NMOD + nn] = s + a.in[I_BADA][layer * NMOD + nn]; }
            __syncthreads();
        }
    }
    {
        LAS float* scr = (LAS float*)(L + 32768 + wave * 8704);
        constexpr int I_IN = 16 * 64, I_OUT = 16 * 32, I_Q_ = 16 * 64, PER_L = I_IN + I_OUT + I_Q_, NPAIR = DEPTH * PER_L / 2;
        int p0, pend, pstep;
        if (G == 256) { if (vcu < 192) { p0 = gw; pend = p0 + 1; } else { p0 = 1536 + 2 * ((vcu - 192) * NWAVES + wave); pend = p0 + 2; } pstep = 1; }
        else { p0 = gw; pend = NPAIR; pstep = NGW; }
        for (int pp = p0; pp < pend && pp < NPAIR; pp += pstep) {
            TItem t[2];
#pragma unroll
            for (int q = 0; q < 2; ++q) { const int it = 2 * pp + q; const int layer = it / PER_L; int r = it % PER_L;
                if (r < I_IN) { t[q].W = a.in[I_WIN] + (size_t)layer * D * D_IN; t[q].N = D_IN; t[q].WT = (bf16*)(ws + WS_WIN) + (size_t)layer * D_IN * D; t[q].ks = nullptr; }
                else if (r < I_IN + I_OUT) { r -= I_IN; t[q].W = a.in[I_WOUT] + (size_t)layer * D * D; t[q].N = D; t[q].WT = (bf16*)(ws + WS_WOUT) + (size_t)layer * D * D; t[q].ks = a.in[I_MIXG] + layer * D; }
                else { r -= I_IN + I_OUT; t[q].W = a.in[I_WQ] + (size_t)layer * D * 2048; t[q].N = 2048; t[q].WT = (bf16*)(ws + WS_WQ) + (size_t)layer * 2048 * D; t[q].ks = nullptr; }
                const int nblk = t[q].N / 32; t[q].k0 = 64 * (r / nblk); t[q].n0 = 32 * (r % nblk); }
            float ta[32], tb[32];
            titem_load(t[0], lane, ta); titem_load(t[1], lane, tb);
            titem_finish(t[0], lane, ta, scr); titem_finish(t[1], lane, tb, scr);
        }
    }
    for (int g8 = vcu * 512 + tid; g8 < DEPTH * 4 * 128 * 128 / 8; g8 += G * 512) {
        const f32x4 k0 = *(const f32x4*)(a.in[I_SGUW] + (size_t)g8 * 8), k1 = *(const f32x4*)(a.in[I_SGUW] + (size_t)g8 * 8 + 4);
        v4u o; o.x = pk2(k0.x, k0.y); o.y = pk2(k0.z, k0.w); o.z = pk2(k1.x, k1.y); o.w = pk2(k1.z, k1.w);
        *(GAS v4u*)((bf16*)(ws + WS_SGUW) + (size_t)g8 * 8) = o;
    }
    for (int g8 = vcu * 512 + tid; g8 < DEPTH * 8 * 2 * 128 * 128 / 8; g8 += G * 512) {
        const f32x4 k0 = *(const f32x4*)(a.in[I_KEYS] + (size_t)g8 * 8), k1 = *(const f32x4*)(a.in[I_KEYS] + (size_t)g8 * 8 + 4);
        v4u o; o.x = pk2(k0.x, k0.y); o.y = pk2(k0.z, k0.w); o.z = pk2(k1.x, k1.y); o.w = pk2(k1.z, k1.w);
        *(GAS v4u*)((bf16*)(ws + WS_KEYS) + (size_t)g8 * 8) = o;
    }
    { const int gt = vcu * 512 + tid;
      if (gt < 192 * 16) { const int idx = gt >> 4, j = gt & 15; const float pos = (float)(idx < 128 ? idx : idx - 128);
          const float inv = powf(10000.0f, -(float)j / 16.0f); const float ang = pos * inv;
          ((float*)(ws + WS_ROPE))[2 * gt] = cosf(ang); ((float*)(ws + WS_ROPE))[2 * gt + 1] = sinf(ang); } }
}

__device__ __forceinline__ void norm_row_store(const f32x4 (&v)[4], float rs, const float* g, const float* sc, const float* sh, bf16* dst, int lane) {
#pragma unroll
    for (int j = 0; j < 4; ++j) { const int c = 4 * lane + 256 * j;
        const f32x4 g4 = *(const f32x4*)(g + c), s4 = *(const f32x4*)(sc + c), h4 = *(const f32x4*)(sh + c);
        const f32x4 o = v[j] * rs * g4 * (s4 + 1.0f) + h4;
        *(GAS unsigned long long*)(dst + c) = (unsigned long long)pk2(o.x, o.y) | ((unsigned long long)pk2(o.z, o.w) << 32); }
}
__device__ __forceinline__ int ncol(int lane, int q) { return 8 * lane + 512 * (q >> 1) + 4 * (q & 1); }
struct NormMods { f32x4 gw[4], sh[4]; };
__device__ __forceinline__ void load_mods(NormMods& M, const float* g, const float* mm, int shift_idx, int scale_idx, int lane) {
#pragma unroll
    for (int j = 0; j < 4; ++j) { const int c = ncol(lane, j); M.gw[j] = *(const f32x4*)(g + c) * (*(const f32x4*)(mm + scale_idx * D + c) + 1.0f); M.sh[j] = *(const f32x4*)(mm + shift_idx * D + c); }
}
__device__ __forceinline__ void norm_one(const f32x4 (&v)[4], int r, const NormMods& M, bf16* XN, signed char* h8, float* hsc, int lane) {
    float ss = 0.f;
#pragma unroll
    for (int j = 0; j < 4; ++j) ss += (v[j].x * v[j].x + v[j].y * v[j].y) + (v[j].z * v[j].z + v[j].w * v[j].w);
    const float rs = rsqrtf(wave_sum(ss) * (1.0f / D) + EPS);
    f32x4 o[4]; float mx = 0.f;
#pragma unroll
    for (int j = 0; j < 4; ++j) { o[j] = v[j] * rs * M.gw[j] + M.sh[j]; mx = fmaxf(mx, fmaxf(fmaxf(fabsf(o[j].x), fabsf(o[j].y)), fmaxf(fabsf(o[j].z), fabsf(o[j].w)))); }
#pragma unroll
    for (int j = 0; j < 2; ++j) { v4u w; w.x = pk2(o[2 * j].x, o[2 * j].y); w.y = pk2(o[2 * j].z, o[2 * j].w); w.z = pk2(o[2 * j + 1].x, o[2 * j + 1].y); w.w = pk2(o[2 * j + 1].z, o[2 * j + 1].w);
        *(GAS v4u*)(XN + (size_t)r * D + 8 * lane + 512 * j) = w; }
    if (h8) {
        mx = fmaxf(wave_max(mx), 1e-30f); const float inv = 127.0f / mx;
#pragma unroll
        for (int j = 0; j < 2; ++j) { unsigned w2[2];
#pragma unroll
            for (int hf = 0; hf < 2; ++hf) { unsigned w = 0;
#pragma unroll
                for (int i = 0; i < 4; ++i) { int q = (int)rintf(o[2 * j + hf][i] * inv); q = q < -127 ? -127 : (q > 127 ? 127 : q); w |= (unsigned)(q & 255) << (8 * i); }
                w2[hf] = w; }
            *(GAS unsigned long long*)(h8 + (size_t)r * D + 8 * lane + 512 * j) = (unsigned long long)w2[0] | ((unsigned long long)w2[1] << 32); }
        if (lane == 0) hsc[r] = mx * (1.0f / 127.0f);
    }
}
__device__ __forceinline__ void load_row4(const float* src_c, const float* src_l, const bf16* X, int r, int lane, f32x4 (&v)[4]) {
    if (X) {
#pragma unroll
        for (int j = 0; j < 2; ++j) { const v4u w = *(const GAS v4u*)(X + (size_t)r * D + 8 * lane + 512 * j);
            v[2 * j] = (f32x4){bflo(w.x), bfhi(w.x), bflo(w.y), bfhi(w.y)}; v[2 * j + 1] = (f32x4){bflo(w.z), bfhi(w.z), bflo(w.w), bfhi(w.w)}; }
    } else { const float* x = r < R_CTX ? src_c + (size_t)r * D : src_l + (size_t)(r - R_CTX) * D;
#pragma unroll
        for (int j = 0; j < 4; ++j) v[j] = *(const f32x4*)(x + ncol(lane, j)); }
}
__device__ __forceinline__ void ph_norm(const float* src_c, const float* src_l, const bf16* X, const float* g, const float* modsL, int shift_idx, int scale_idx, bf16* XN, signed char* h8, float* hsc, int row_lo, int gw, int NGW, int lane) {
    for (int r = row_lo + gw; r < R; r += 4 * NGW) {
        const int rr[4] = {r, r + NGW, r + 2 * NGW, r + 3 * NGW};
        f32x4 v0[4], v1[4], v2[4], v3[4];
        load_row4(src_c, src_l, X, r, lane, v0); load_row4(src_c, src_l, X, rr[1] < R ? rr[1] : r, lane, v1); load_row4(src_c, src_l, X, rr[2] < R ? rr[2] : r, lane, v2); load_row4(src_c, src_l, X, rr[3] < R ? rr[3] : r, lane, v3);
        int mb = row_modb(r); NormMods M; load_mods(M, g, modsL + (size_t)mb * NMOD, shift_idx, scale_idx, lane);
        norm_one(v0, r, M, XN, h8, hsc, lane);
        if (rr[1] < R) { const int m2 = row_modb(rr[1]); if (m2 != mb) { mb = m2; load_mods(M, g, modsL + (size_t)mb * NMOD, shift_idx, scale_idx, lane); } norm_one(v1, rr[1], M, XN, h8, hsc, lane); }
        if (rr[2] < R) { const int m2 = row_modb(rr[2]); if (m2 != mb) { mb = m2; load_mods(M, g, modsL + (size_t)mb * NMOD, shift_idx, scale_idx, lane); } norm_one(v2, rr[2], M, XN, h8, hsc, lane); }
        if (rr[3] < R) { const int m2 = row_modb(rr[3]); if (m2 != mb) { mb = m2; load_mods(M, g, modsL + (size_t)mb * NMOD, shift_idx, scale_idx, lane); } norm_one(v3, rr[3], M, XN, h8, hsc, lane); }
    }
}
__device__ __forceinline__ void ph_final(const bf16* X, float* out, const float* fg, int gw, int NGW, int lane) {
    f32x4 g4[4];
#pragma unroll
    for (int j = 0; j < 4; ++j) g4[j] = *(const f32x4*)(fg + ncol(lane, j));
    for (int r = gw; r < R_LAT; r += 4 * NGW) {
        f32x4 v[4][4];
#pragma unroll
        for (int q = 0; q < 4; ++q) load_row4(nullptr, nullptr, X, R_CTX + (r + q * NGW < R_LAT ? r + q * NGW : r), lane, v[q]);
#pragma unroll
        for (int q = 0; q < 4; ++q) { const int rq = r + q * NGW; if (rq < R_LAT) { float ss = 0.f;
#pragma unroll
            for (int j = 0; j < 4; ++j) ss += (v[q][j].x * v[q][j].x + v[q][j].y * v[q][j].y) + (v[q][j].z * v[q][j].z + v[q][j].w * v[q][j].w);
            const float rs = rsqrtf(wave_sum(ss) * (1.0f / D) + EPS); float* x = out + (size_t)rq * D;
#pragma unroll
            for (int j = 0; j < 4; ++j) *(f32x4*)(x + ncol(lane, j)) = v[q][j] * rs * g4[j]; } }
    }
}
typedef short s16x4p __attribute__((ext_vector_type(4)));
__device__ __forceinline__ s16x4p vtr_p(const LAS unsigned char* p) { return __builtin_bit_cast(s16x4p, __builtin_amdgcn_ds_read_tr16_b64_v4i16((LAS s16x4p*)p)); }
constexpr int SG_VP = 544, SG_SP = 528;
__device__ __forceinline__ void post_conv_item(const bf16* P, bf16* Y, const float* cw, int r, int grp) {
    const bool isc = r < R_CTX; const int t = row_t(r), len = isc ? CTXL : SEQ;
    const bf16* p = P + (size_t)r * D_IN + grp * 8;
    const bool h0 = t > 0, h2 = t < len - 1;
    const v4u z4 = (v4u){0u, 0u, 0u, 0u};
    const v4u wb = *(const GAS v4u*)(p + C_CONVB), wc1 = *(const GAS v4u*)(p + C_CONVC), wx1 = *(const GAS v4u*)(p + C_CONVX);
    const v4u wc0 = h0 ? *(const GAS v4u*)(p - D_IN + C_CONVC) : z4, wx0 = h0 ? *(const GAS v4u*)(p - D_IN + C_CONVX) : z4;
    const v4u wc2 = h2 ? *(const GAS v4u*)(p + D_IN + C_CONVC) : z4, wx2 = h2 ? *(const GAS v4u*)(p + D_IN + C_CONVX) : z4;
    float b[8], c1[8], x1[8], c0[8], x0[8], c2[8], x2[8];
    unpack8(wb, b); unpack8(wc1, c1); unpack8(wx1, x1); unpack8(wc0, c0); unpack8(wx0, x0); unpack8(wc2, c2); unpack8(wx2, x2);
    float y[8]; float ss = 0.f;
#pragma unroll
    for (int e = 0; e < 8; ++e) { const int cc = grp * 8 + e; y[e] = b[e] * (c0[e] * x0[e] * cw[cc] + c1[e] * x1[e] * cw[256 + cc] + c2[e] * x2[e] * cw[512 + cc]); ss += y[e] * y[e]; }
    const float rs = rsqrtf(half_sum32(ss) * (1.0f / 256.0f) + EPS);
#pragma unroll
    for (int e = 0; e < 8; ++e) y[e] *= rs;
    *(GAS v4u*)(Y + (size_t)r * D + grp * 8) = pack8(y);
}
__device__ __forceinline__ void post_qkv_item(const bf16* P, bf16* Qb, bf16* Kb, bf16* Vb, const float* rope, int r, int it, bool skipq) {
    const bool isc = r < R_CTX; const bf16* p = P + (size_t)r * D_IN;
    if (it < 40) {
        const int head = it >> 2, sub = it & 3, d0 = (sub & 1) * 8 + (sub >> 1) * 32;
        if (head < 8 && skipq) return;
        const bf16* src = p + (head < 8 ? C_Q + head * 64 : C_K + (head - 8) * 64) + d0;
        float x[8], y[8]; unpack8(*(const GAS v4u*)src, x); unpack8(*(const GAS v4u*)(src + 16), y);
        float oa[8], ob[8];
        if (!isc) { const int t = (r - R_CTX) & 8191; const int ti = (sub >> 1) ? 128 + (t & 63) : (t >> 6);
            const float* tb = rope + ((size_t)ti * 16 + (sub & 1) * 8) * 2;
#pragma unroll
            for (int e = 0; e < 8; e += 2) { const f32x4 cs4 = *(const f32x4*)(tb + 2 * e);
                oa[e] = x[e] * cs4.x - y[e] * cs4.y; ob[e] = y[e] * cs4.x + x[e] * cs4.y; oa[e + 1] = x[e + 1] * cs4.z - y[e + 1] * cs4.w; ob[e + 1] = y[e + 1] * cs4.z + x[e + 1] * cs4.w; } }
        else {
#pragma unroll
            for (int e = 0; e < 8; ++e) { oa[e] = x[e]; ob[e] = y[e]; } }
        if (head < 8) {
#pragma unroll
            for (int e = 0; e < 8; ++e) { oa[e] *= QSCALE; ob[e] *= QSCALE; }
            bf16* dst = Qb + (size_t)r * 512 + head * 64 + d0; *(GAS v4u*)dst = pack8(oa); *(GAS v4u*)(dst + 16) = pack8(ob);
        } else { bf16* dst = Kb + (size_t)r * 128 + (head - 8) * 64 + d0; *(GAS v4u*)dst = pack8(oa); *(GAS v4u*)(dst + 16) = pack8(ob); }
    } else {
        const int g = it - 40; const bf16* src = p + C_V + g * 16; bf16* dst = Vb + (size_t)r * 128 + g * 16;
        const v4u v0 = *(const GAS v4u*)src, v1 = *(const GAS v4u*)(src + 8); *(GAS v4u*)dst = v0; *(GAS v4u*)(dst + 8) = v1;
    }
}
__device__ __forceinline__ void ph_post(const Args& a, int layer, bool last, LAS unsigned char* L, int tid, int lane, int wave, int vcu, int G) {
    unsigned char* ws = a.ws;
    const bf16* P = (const bf16*)(ws + WS_P); bf16* Y = (bf16*)(ws + WS_Y); bf16* Qb = (bf16*)(ws + WS_Q); bf16* Kb = (bf16*)(ws + WS_K); bf16* Vb = (bf16*)(ws + WS_V);
    const float* cw = a.in[I_CONVW] + layer * 3 * 256; const float* gn = a.in[I_SGUG] + layer * 256;
    const bf16* sw = (const bf16*)(ws + WS_SGUW) + (size_t)layer * 4 * 128 * 128; const float* sb = a.in[I_SGUB] + layer * 4 * 128;
    const float* rope = (const float*)(ws + WS_ROPE);
    const int rlo2 = last ? R_CTX : 0;
    LAS unsigned char* vbuf = L; LAS unsigned char* sbuf = L + 128 * SG_VP;
    for (int ch = rlo2 / 128 + vcu; ch < R / 128; ch += G) {
        const int r0 = ch * 128;
        bf16x8 afr[4][4];
        { const int hh = wave >> 1, ph = wave & 1, n = lane & 15, kg = lane >> 4; const bf16* wp = sw + ((size_t)hh * 128 + 64 * ph + n) * 128 + 8 * kg;
#pragma unroll
          for (int ks = 0; ks < 4; ++ks)
#pragma unroll
              for (int m = 0; m < 4; ++m) afr[ks][m] = *(const GAS bf16x8*)(wp + (size_t)(16 * m) * 128 + 32 * ks); }
        v4u uin[8];
        { v4u vin[8];
#pragma unroll
          for (int i = 0; i < 8; ++i) { const int idx = tid + 512 * i; vin[i] = *(const GAS v4u*)(P + (size_t)(r0 + (idx >> 5)) * D_IN + C_SGUV + (idx & 31) * 8); }
#pragma unroll
          for (int i = 0; i < 8; ++i) { const int idx = tid + 512 * i; uin[i] = *(const GAS v4u*)(P + (size_t)(r0 + (idx >> 5)) * D_IN + C_SGUU + (idx & 31) * 8); }
#pragma unroll
          for (int i = 0; i < 8; ++i) { const int idx = tid + 512 * i, row = idx >> 5, grp = idx & 31;
              float v[8]; unpack8(vin[i], v); float s = 0.f;
#pragma unroll
              for (int e = 0; e < 8; ++e) { v[e] = gelu_tanh(v[e]); s += v[e]; }
              const float mu = half_sum32(s) * (1.0f / 256.0f); float q = 0.f;
#pragma unroll
              for (int e = 0; e < 8; ++e) { v[e] -= mu; q += v[e] * v[e]; }
              const float rs = rsqrtf(half_sum32(q) * (1.0f / 256.0f) + EPS);
#pragma unroll
              for (int e = 0; e < 8; ++e) v[e] = v[e] * rs * gn[grp * 8 + e];
              *(LAS v4u*)(vbuf + row * SG_VP + grp * 16) = pack8(v); } }
        __syncthreads();
        { const int hh = wave >> 1, ph = wave & 1, n = lane & 15, kg = lane >> 4;
          f32x4 acc[4][4];
#pragma unroll
          for (int m = 0; m < 4; ++m)
#pragma unroll
              for (int ct = 0; ct < 4; ++ct) acc[m][ct] = (f32x4){0.f, 0.f, 0.f, 0.f};
          const LAS unsigned char* vb = vbuf + (8 * kg + (n >> 2)) * SG_VP + (hh * 64 + 4 * (n & 3)) * 2;
#pragma unroll
          for (int ks = 0; ks < 4; ++ks) {
              bf16x8 bfr[4];
#pragma unroll
              for (int ct = 0; ct < 4; ++ct) { const s16x4p lo = vtr_p(vb + (32 * ks) * SG_VP + ct * 32), hi4 = vtr_p(vb + (32 * ks + 4) * SG_VP + ct * 32);
                  bfr[ct] = (bf16x8){lo[0], lo[1], lo[2], lo[3], hi4[0], hi4[1], hi4[2], hi4[3]}; }
#pragma unroll
              for (int m = 0; m < 4; ++m)
#pragma unroll
                  for (int ct = 0; ct < 4; ++ct) acc[m][ct] = __builtin_amdgcn_mfma_f32_16x16x32_bf16(afr[ks][m], bfr[ct], acc[m][ct], 0, 0, 0);
          }
#pragma unroll
          for (int m = 0; m < 4; ++m) { const int pb = 64 * ph + 16 * m + 4 * kg; const f32x4 bias = *(const f32x4*)(sb + hh * 128 + pb);
#pragma unroll
              for (int ct = 0; ct < 4; ++ct)
#pragma unroll
                  for (int e = 0; e < 4; ++e) *(LAS unsigned short*)(sbuf + (pb + e) * SG_SP + (hh * 64 + 16 * ct + n) * 2) = (unsigned short)f2bf(acc[m][ct][e] + bias[e]); } }
        __syncthreads();
        {
#pragma unroll
          for (int i = 0; i < 8; ++i) { const int idx = tid + 512 * i, row = idx >> 5, grp = idx & 31;
              float u[8], s8[8]; unpack8(uin[i], u); unpack8(*(const LAS v4u*)(sbuf + row * SG_SP + grp * 16), s8); float ss = 0.f;
#pragma unroll
              for (int e = 0; e < 8; ++e) { u[e] = gelu_tanh(u[e]) * s8[e]; ss += u[e] * u[e]; }
              const float rs = rsqrtf(half_sum32(ss) * (1.0f / 256.0f) + EPS);
#pragma unroll
              for (int e = 0; e < 8; ++e) u[e] *= rs;
              *(GAS v4u*)(Y + (size_t)(r0 + row) * D + 256 + grp * 8) = pack8(u); } }
        __syncthreads();
    }
    { const int nch = (R - rlo2) / 128, nh = (nch > G && nch < 2 * G && 4 * (nch - G) < G) ? nch - G : 0;
      const int nit = (R - rlo2) * 32, gt = (vcu - nh) * 512 + tid, GT = (G - nh) * 512;
      if (vcu >= nh)
      for (int it = gt; it < nit; it += 4 * GT) {
#pragma unroll
          for (int q = 0; q < 4; ++q) { const int i2 = it + q * GT; if (i2 < nit) post_conv_item(P, Y, cw, rlo2 + (i2 >> 5), i2 & 31); } } }
    { const int nit = R * 48, gt = vcu * 512 + tid, GT = G * 512;
      for (int it = gt; it < nit; it += 4 * GT) {
#pragma unroll
          for (int q = 0; q < 4; ++q) { const int i2 = it + q * GT; if (i2 < nit) { const int r = i2 / 48; post_qkv_item(P, Qb, Kb, Vb, rope, r, i2 % 48, last && r < R_CTX); } } } }
}

__device__ __forceinline__ void ph_attn_simple(const Args& a, int layer, int row_lo, LAS unsigned char* L, int lane, int wave, int gw, int NGW) {
    unsigned char* ws = a.ws;
    const bf16* Qb = (const bf16*)(ws + WS_Q); const bf16* Kb = (const bf16*)(ws + WS_K); const bf16* Vb = (const bf16*)(ws + WS_V);
    bf16* Y = (bf16*)(ws + WS_Y); float* ssq = (float*)(ws + WS_SSQ);
    LAS float* pb = (LAS float*)(L + wave * 2560);
    const int nitems = (R - row_lo) * 8;
    for (int item = gw; item < nitems; item += NGW) {
        const int r = row_lo + (item >> 3), head = item & 7, kvh = head >> 2;
#ifdef EXP_EDGE
        { const int tq = r >= R_CTX ? ((r - R_CTX) & 8191) >> 6 : -1; if (tq >= 2 && tq <= 125) continue; }
#endif
        const bool lat = r >= R_CTX; const int b = lat ? ((r - R_CTX) >> 13) : (r >> 8);
        const int cbase = b * CTXL; int lo = 0, nloc = 0;
        if (lat) { const int t = (r - R_CTX) & 8191; const int tlo = t - 128 < 0 ? 0 : t - 128, thi = t + 128 > SEQ - 1 ? SEQ - 1 : t + 128; lo = r - (t - tlo); nloc = thi - tlo + 1; }
        const int nk = CTXL + nloc;
        float q[64];
        { const bf16* qp = Qb + (size_t)r * 512 + head * 64;
#pragma unroll
          for (int k8 = 0; k8 < 8; ++k8) { float f[8]; unpack8(*(const GAS v4u*)(qp + k8 * 8), f);
#pragma unroll
              for (int e = 0; e < 8; ++e) q[k8 * 8 + e] = f[e]; } }
        const float sink2 = a.in[I_SINK][layer * 8 + head] * LOG2E;
        float mx = sink2;
        for (int i = lane; i < nk; i += 64) {
            const int kr = i < CTXL ? cbase + i : lo + (i - CTXL);
            const bf16* kp = Kb + (size_t)kr * 128 + kvh * 64; float s = 0.f;
#pragma unroll
            for (int k8 = 0; k8 < 8; ++k8) { float f[8]; unpack8(*(const GAS v4u*)(kp + k8 * 8), f);
#pragma unroll
                for (int e = 0; e < 8; ++e) s += q[k8 * 8 + e] * f[e]; }
            pb[i] = s; mx = fmaxf(mx, s);
        }
        mx = wave_max(mx); float den = 0.f;
        for (int i = lane; i < nk; i += 64) { const float e = exp2f(pb[i] - mx); pb[i] = e; den += e; }
        den = wave_sum(den) + exp2f(sink2 - mx);
        LDS_WAIT();
        float o = 0.f;
        for (int i = 0; i < nk; ++i) { const int kr = i < CTXL ? cbase + i : lo + (i - CTXL); o += pb[i] * bf2f(Vb[(size_t)kr * 128 + kvh * 64 + lane]); }
        o /= den;
        Y[(size_t)r * D + 512 + head * 64 + lane] = (bf16)f2bf(o);
        const float s2 = wave_sum(o * o);
        if (lane == 0) ssq[(size_t)r * 8 + head] = s2;
        LDS_WAIT();
    }
}
__device__ __forceinline__ void ph_attn_norm(const Args& a, int row_lo, int lane, int gw, int NGW) {
    bf16* Y = (bf16*)(a.ws + WS_Y); const float* ssq = (const float*)(a.ws + WS_SSQ);
    for (int r = row_lo + gw; r < R; r += NGW) {
        const f32x4 s0 = *(const f32x4*)(ssq + (size_t)r * 8), s1 = *(const f32x4*)(ssq + (size_t)r * 8 + 4);
        const float rs = rsqrtf(((s0.x + s0.y) + (s0.z + s0.w) + (s1.x + s1.y) + (s1.z + s1.w)) * (1.0f / 512.0f) + EPS);
        bf16* y = Y + (size_t)r * D + 512 + lane * 8; float f[8]; unpack8(*(const GAS v4u*)y, f);
#pragma unroll
        for (int e = 0; e < 8; ++e) f[e] *= rs;
        *(GAS v4u*)y = pack8(f);
    }
}

__device__ __forceinline__ void ph_topk_simple(const Args& a, int layer, int row_lo, LAS unsigned char* L, int tid, int vcu, int G) {
    const bf16* QP = (const bf16*)(a.ws + WS_P); int* eidx = (int*)(a.ws + WS_EIDX); float* egate = (float*)(a.ws + WS_GATE);
    const float* keys = a.in[I_KEYS] + (size_t)layer * 8 * 2 * 128 * 128;
    const int hw = tid >> 8, t = tid & 255, p = t >> 7, k = t & 127;
    LAS float* qs = (LAS float*)(L + hw * 4096); LAS float* sc = qs + 256; LAS float* cand = sc + 256; LAS float* sv = cand + 256; LAS int* si = (LAS int*)(sv + 32); LAS float* fv = (LAS float*)(si + 32); LAS int* fe = (LAS int*)(fv + 16);
    const int nitems = (R - row_lo) * 8, NVB = 2 * G, iters = (nitems + NVB - 1) / NVB;
    for (int itn = 0; itn < iters; ++itn) {
        const int item = itn * NVB + vcu * 2 + hw; const bool act = item < nitems;
        const int r = row_lo + (act ? item >> 3 : 0), h = item & 7;
        qs[t] = bf2f(QP[(size_t)r * 2048 + h * 256 + t]);
        __syncthreads();
        { const float* kp = keys + (((size_t)h * 2 + p) * 128 + k) * 128; float s = 0.f;
#pragma unroll 8
          for (int d = 0; d < 128; d += 4) { const f32x4 kv = *(const f32x4*)(kp + d); s += qs[p * 128 + d] * kv.x + qs[p * 128 + d + 1] * kv.y + qs[p * 128 + d + 2] * kv.z + qs[p * 128 + d + 3] * kv.w; }
          sc[t] = s; }
        __syncthreads();
        { const float my = sc[t]; int rank = 0;
          for (int j = 0; j < 128; ++j) { const float o = sc[p * 128 + j]; rank += (o > my || (o == my && j < k)) ? 1 : 0; }
          if (rank < 16) { sv[p * 16 + rank] = my; si[p * 16 + rank] = k; } }
        __syncthreads();
        cand[t] = sv[t >> 4] + sv[16 + (t & 15)];
        __syncthreads();
        { const float my = cand[t]; int rank = 0;
          for (int j = 0; j < 256; ++j) { const float o = cand[j]; rank += (o > my || (o == my && j < t)) ? 1 : 0; }
          if (rank < 16) { fv[rank] = my; fe[rank] = si[t >> 4] * 128 + si[16 + (t & 15)]; } }
        __syncthreads();
        if (t < 16 && act) { const float m = fv[0]; float den = 0.f;
#pragma unroll
            for (int j = 0; j < 16; ++j) den += __expf(fv[j] - m);
            eidx[(size_t)r * 128 + h * 16 + t] = fe[t]; egate[(size_t)r * 128 + h * 16 + t] = __expf(fv[t] - m) / den; }
        __syncthreads();
    }
}

typedef float f32x16 __attribute__((ext_vector_type(16)));
typedef short s16x4 __attribute__((ext_vector_type(4)));
typedef float f32x2_t __attribute__((ext_vector_type(2))); typedef __bf16 bf16x2_t __attribute__((ext_vector_type(2)));
__device__ __forceinline__ unsigned cvtpk(float lo, float hi) { f32x2_t v = {lo, hi}; bf16x2_t b = __builtin_convertvector(v, bf16x2_t); return __builtin_bit_cast(unsigned, b); }
__device__ __forceinline__ int crow(int r, int hi) { return (r & 3) + 8 * (r >> 2) + 4 * hi; }
__device__ __forceinline__ s16x4 vtr(const LAS unsigned char* p) { return __builtin_bit_cast(s16x4, __builtin_amdgcn_ds_read_tr16_b64_v4i16((LAS s16x4*)p)); }
__device__ __forceinline__ unsigned xhalf_other_u(unsigned v, int hi) { unsigned a_ = v, b_ = v; asm volatile("" : "+v"(a_), "+v"(b_)); auto rr = __builtin_amdgcn_permlane32_swap(a_, b_, false, false); return hi ? rr[0] : rr[1]; }
__device__ __forceinline__ float xhalf_max(float m, int hi) { return fmaxf(m, __builtin_bit_cast(float, xhalf_other_u(__builtin_bit_cast(unsigned, m), hi))); }
__device__ __forceinline__ float xhalf_sum(float m, int hi) { return m + __builtin_bit_cast(float, xhalf_other_u(__builtin_bit_cast(unsigned, m), hi)); }
constexpr int AT_ROWB = 144;
__device__ __forceinline__ void ph_attn(const Args& a, int layer, bool last, LAS unsigned char* L, int tid, int lane, int wave, int vcu, int G) {
    unsigned char* ws = a.ws;
    const bf16* Qb = (const bf16*)(ws + WS_Q); const bf16* Kb = (const bf16*)(ws + WS_K); const bf16* Vb = (const bf16*)(ws + WS_V);
    bf16* Y = (bf16*)(ws + WS_Y); float* ssq = (float*)(ws + WS_SSQ);
    const int hi = lane >> 5, l31 = lane & 31;
    constexpr int AT_BUF = 2 * 64 * AT_ROWB;
    LAS float* wsf = (LAS float*)(L + 2 * AT_BUF + wave * 256);
    LAS unsigned char* stg = L + 2 * AT_BUF + 8 * 256 + wave * (32 * AT_ROWB);
    const int nunits = 1024 + (last ? 0 : 32);
    const int ldrow = tid >> 3, ldch = tid & 7;
    for (int u = vcu; u < nunits; u += G) {
        int b, qblk, kvh; bool isc;
        if (u < 1024) { isc = false; kvh = u & 1; qblk = (u >> 1) & 127; b = u >> 8; } else { const int v = u - 1024; isc = true; kvh = v & 1; qblk = (v >> 1) & 3; b = v >> 3; }
#ifdef EXP_EDGE
        if (isc || qblk < 2 || qblk > 125) continue;
#endif
        const int qrow0 = isc ? b * CTXL + qblk * 64 : R_CTX + b * SEQ + qblk * 64;
        const int hq = kvh * 4 + (wave >> 1), qsub = wave & 1;
        const int lo_off = qblk < 2 ? -qblk : -2, hi_off = qblk > 125 ? 127 - qblk : 2;
        const int nt = isc ? 4 : 4 + (hi_off - lo_off + 1);
        bf16x8 qr[4];
        { const bf16* qp = Qb + (size_t)(qrow0 + 32 * qsub + l31) * 512 + hq * 64 + 8 * hi;
#pragma unroll
          for (int d0 = 0; d0 < 4; ++d0) qr[d0] = *(const GAS bf16x8*)(qp + 16 * d0); }
        const float sink2 = a.in[I_SINK][layer * 8 + hq] * LOG2E;
        float mrun = sink2, lrun = hi == 0 ? 1.0f : 0.0f;
        f32x16 o0 = {}, o1 = {};
        v4u kreg, vreg;
        { const int kr = b * CTXL + ldrow;
          kreg = *(const GAS v4u*)(Kb + (size_t)kr * 128 + kvh * 64 + ldch * 8); vreg = *(const GAS v4u*)(Vb + (size_t)kr * 128 + kvh * 64 + ldch * 8); }
#define AT_LOADT(TN) { const int tn_ = (TN); const int kr_ = (tn_ < 4 ? b * CTXL + 64 * tn_ : R_CTX + b * SEQ + 64 * (qblk + lo_off + tn_ - 4)) + ldrow; \
            kreg = *(const GAS v4u*)(Kb + (size_t)kr_ * 128 + kvh * 64 + ldch * 8); vreg = *(const GAS v4u*)(Vb + (size_t)kr_ * 128 + kvh * 64 + ldch * 8); }
        __syncthreads();
        *(LAS v4u*)(L + ldrow * AT_ROWB + ldch * 16) = kreg; *(LAS v4u*)(L + 64 * AT_ROWB + ldrow * AT_ROWB + ldch * 16) = vreg;
        if (1 < nt) AT_LOADT(1)
#pragma unroll 1
        for (int ti = 0; ti < nt; ++ti) {
            __syncthreads();
            LAS unsigned char* Ks = L + (ti & 1) * AT_BUF; LAS unsigned char* Vs = Ks + 64 * AT_ROWB;
            if (ti + 1 < nt) { LAS unsigned char* Kn = L + ((ti + 1) & 1) * AT_BUF;
                *(LAS v4u*)(Kn + ldrow * AT_ROWB + ldch * 16) = kreg; *(LAS v4u*)(Kn + 64 * AT_ROWB + ldrow * AT_ROWB + ldch * 16) = vreg;
                if (ti + 2 < nt) AT_LOADT(ti + 2) }
            const int off = ti < 4 ? 0 : lo_off + ti - 4; const int mtype = off == -2 ? 1 : (off == 2 ? 2 : 0);
            f32x16 p0 = {}, p1 = {};
#pragma unroll
            for (int d0 = 0; d0 < 4; ++d0) {
                const bf16x8 k0 = *(const LAS bf16x8*)(Ks + l31 * AT_ROWB + d0 * 32 + hi * 16);
                const bf16x8 k1 = *(const LAS bf16x8*)(Ks + (l31 + 32) * AT_ROWB + d0 * 32 + hi * 16);
                p0 = __builtin_amdgcn_mfma_f32_32x32x16_bf16(k0, qr[d0], p0, 0, 0, 0);
                p1 = __builtin_amdgcn_mfma_f32_32x32x16_bf16(k1, qr[d0], p1, 0, 0, 0);
            }
            if (mtype != 0) {
                int qi = 32 * qsub + l31; asm volatile("" : "+v"(qi));
#pragma unroll
                for (int r = 0; r < 16; ++r) { const int j0 = crow(r, hi), j1 = j0 + 32;
                    const bool ok0 = mtype == 1 ? (j0 >= qi) : (j0 <= qi), ok1 = mtype == 1 ? (j1 >= qi) : (j1 <= qi);
                    p0[r] = ok0 ? p0[r] : -INFINITY; p1[r] = ok1 ? p1[r] : -INFINITY; }
            }
            float mx = fmaxf(p0[0], p1[0]);
#pragma unroll
            for (int r = 1; r < 16; ++r) mx = fmaxf(mx, fmaxf(p0[r], p1[r]));
            mx = xhalf_max(mx, hi);
            const float mnew = fmaxf(mrun, mx), alpha = __builtin_amdgcn_exp2f(mrun - mnew); mrun = mnew;
            float rs = 0.f;
#pragma unroll
            for (int r = 0; r < 16; ++r) { p0[r] = __builtin_amdgcn_exp2f(p0[r] - mnew); p1[r] = __builtin_amdgcn_exp2f(p1[r] - mnew); rs += p0[r] + p1[r]; }
            lrun = lrun * alpha + rs;
            if (__builtin_amdgcn_ballot_w64(alpha != 1.0f) != 0ull) {
                if (hi == 0) wsf[l31] = alpha;
#pragma unroll
                for (int g = 0; g < 4; ++g) { const f32x4 al = *(const LAS f32x4*)(wsf + 8 * g + 4 * hi);
#pragma unroll
                    for (int e = 0; e < 4; ++e) { o0[4 * g + e] *= al[e]; o1[4 * g + e] *= al[e]; } }
            }
            const LAS unsigned char* vb = Vs + (4 * hi + ((lane & 15) >> 2)) * AT_ROWB + (16 * ((lane >> 4) & 1) + 4 * (lane & 3)) * 2;
#pragma unroll
            for (int half = 0; half < 2; ++half)
#pragma unroll
                for (int s = 0; s < 2; ++s) {
                    const f32x16& px = half ? p1 : p0;
                    v4u pw; pw.x = cvtpk(px[8 * s + 0], px[8 * s + 1]); pw.y = cvtpk(px[8 * s + 2], px[8 * s + 3]); pw.z = cvtpk(px[8 * s + 4], px[8 * s + 5]); pw.w = cvtpk(px[8 * s + 6], px[8 * s + 7]);
                    const bf16x8 pa = __builtin_bit_cast(bf16x8, pw);
                    const LAS unsigned char* vr = vb + (32 * half + 16 * s) * AT_ROWB;
                    const s16x4 a0 = vtr(vr), a1 = vtr(vr + 8 * AT_ROWB), b0 = vtr(vr + 64), b1 = vtr(vr + 8 * AT_ROWB + 64);
                    const bf16x8 v0 = (bf16x8){a0[0], a0[1], a0[2], a0[3], a1[0], a1[1], a1[2], a1[3]}, v1 = (bf16x8){b0[0], b0[1], b0[2], b0[3], b1[0], b1[1], b1[2], b1[3]};
                    o0 = __builtin_amdgcn_mfma_f32_32x32x16_bf16(pa, v0, o0, 0, 0, 0);
                    o1 = __builtin_amdgcn_mfma_f32_32x32x16_bf16(pa, v1, o1, 0, 0, 0);
                }
        }
        const float lt = xhalf_sum(lrun, hi);
        if (hi == 0) wsf[32 + l31] = 1.0f / lt;
#pragma unroll
        for (int g = 0; g < 4; ++g) { const f32x4 rl = *(const LAS f32x4*)(wsf + 32 + 8 * g + 4 * hi);
#pragma unroll
            for (int e = 0; e < 4; ++e) { const int qrow = 8 * g + 4 * hi + e;
                *(LAS unsigned short*)(stg + qrow * AT_ROWB + l31 * 2) = (unsigned short)f2bf(o0[4 * g + e] * rl[e]);
                *(LAS unsigned short*)(stg + qrow * AT_ROWB + (l31 + 32) * 2) = (unsigned short)f2bf(o1[4 * g + e] * rl[e]); } }
#pragma unroll
        for (int i = 0; i < 4; ++i) { const int row = i * 8 + (lane >> 3), ch = lane & 7; const v4u v = *(const LAS v4u*)(stg + row * AT_ROWB + ch * 16);
            const int rq = qrow0 + 32 * qsub + row;
            *(GAS v4u*)(Y + (size_t)rq * D + 512 + hq * 64 + ch * 8) = v;
            float f[8]; unpack8(v, f); float s2 = 0.f;
#pragma unroll
            for (int e = 0; e < 8; ++e) s2 += f[e] * f[e];
            s2 += dpp_f<0xB1>(s2); s2 += dpp_f<0x4E>(s2); s2 += dpp_f<0x141>(s2);
            if (ch == 0) ssq[(size_t)rq * 8 + hq] = s2; }
    }
}
#define SN_CE(a, b) { const float _hi = __builtin_amdgcn_fmed3f(a, b, kpi); b = __builtin_amdgcn_fmed3f(a, b, kni); a = _hi; }
__device__ __forceinline__ void sort16(float (&v)[16], float kpi, float kni) {
    SN_CE(v[0], v[1])
    SN_CE(v[2], v[3])
    SN_CE(v[4], v[5])
    SN_CE(v[6], v[7])
    SN_CE(v[8], v[9])
    SN_CE(v[10], v[11])
    SN_CE(v[12], v[13])
    SN_CE(v[14], v[15])
    SN_CE(v[0], v[2])
    SN_CE(v[1], v[3])
    SN_CE(v[4], v[6])
    SN_CE(v[5], v[7])
    SN_CE(v[8], v[10])
    SN_CE(v[9], v[11])
    SN_CE(v[12], v[14])
    SN_CE(v[13], v[15])
    SN_CE(v[1], v[2])
    SN_CE(v[5], v[6])
    SN_CE(v[9], v[10])
    SN_CE(v[13], v[14])
    SN_CE(v[0], v[4])
    SN_CE(v[1], v[5])
    SN_CE(v[2], v[6])
    SN_CE(v[3], v[7])
    SN_CE(v[8], v[12])
    SN_CE(v[9], v[13])
    SN_CE(v[10], v[14])
    SN_CE(v[11], v[15])
    SN_CE(v[2], v[4])
    SN_CE(v[3], v[5])
    SN_CE(v[10], v[12])
    SN_CE(v[11], v[13])
    SN_CE(v[1], v[2])
    SN_CE(v[3], v[4])
    SN_CE(v[5], v[6])
    SN_CE(v[9], v[10])
    SN_CE(v[11], v[12])
    SN_CE(v[13], v[14])
    SN_CE(v[0], v[8])
    SN_CE(v[1], v[9])
    SN_CE(v[2], v[10])
    SN_CE(v[3], v[11])
    SN_CE(v[4], v[12])
    SN_CE(v[5], v[13])
    SN_CE(v[6], v[14])
    SN_CE(v[7], v[15])
    SN_CE(v[4], v[8])
    SN_CE(v[5], v[9])
    SN_CE(v[6], v[10])
    SN_CE(v[7], v[11])
    SN_CE(v[2], v[4])
    SN_CE(v[3], v[5])
    SN_CE(v[6], v[8])
    SN_CE(v[7], v[9])
    SN_CE(v[10], v[12])
    SN_CE(v[11], v[13])
    SN_CE(v[1], v[2])
    SN_CE(v[3], v[4])
    SN_CE(v[5], v[6])
    SN_CE(v[7], v[8])
    SN_CE(v[9], v[10])
    SN_CE(v[11], v[12])
    SN_CE(v[13], v[14])
}
__device__ __forceinline__ void bmerge16(float (&v)[16], float kpi, float kni) {
    SN_CE(v[0], v[8])
    SN_CE(v[1], v[9])
    SN_CE(v[2], v[10])
    SN_CE(v[3], v[11])
    SN_CE(v[4], v[12])
    SN_CE(v[5], v[13])
    SN_CE(v[6], v[14])
    SN_CE(v[7], v[15])
    SN_CE(v[0], v[4])
    SN_CE(v[1], v[5])
    SN_CE(v[2], v[6])
    SN_CE(v[3], v[7])
    SN_CE(v[8], v[12])
    SN_CE(v[9], v[13])
    SN_CE(v[10], v[14])
    SN_CE(v[11], v[15])
    SN_CE(v[0], v[2])
    SN_CE(v[1], v[3])
    SN_CE(v[4], v[6])
    SN_CE(v[5], v[7])
    SN_CE(v[8], v[10])
    SN_CE(v[9], v[11])
    SN_CE(v[12], v[14])
    SN_CE(v[13], v[15])
    SN_CE(v[0], v[1])
    SN_CE(v[2], v[3])
    SN_CE(v[4], v[5])
    SN_CE(v[6], v[7])
    SN_CE(v[8], v[9])
    SN_CE(v[10], v[11])
    SN_CE(v[12], v[13])
    SN_CE(v[14], v[15])
}
__device__ __forceinline__ void topmerge16(float (&a)[16], const float (&b)[16], float kpi, float kni) {
#pragma unroll
    for (int i = 0; i < 16; ++i) a[i] = __builtin_amdgcn_fmed3f(a[i], b[15 - i], kpi);
    bmerge16(a, kpi, kni);
}
__device__ __forceinline__ int f2key(float f) { const int b = __builtin_bit_cast(int, f); return b ^ ((b >> 31) & 0x7fffffff); }
__device__ __forceinline__ float key2f(int k) { return __builtin_bit_cast(float, k ^ ((k >> 31) & 0x7fffffff)); }
__device__ __forceinline__ float xhalf_other(float v, int hi) { return __builtin_bit_cast(float, xhalf_other_u(__builtin_bit_cast(unsigned, v), hi)); }
__device__ __forceinline__ float mkkey(float f, int clr, int idx) { return __builtin_bit_cast(float, (__builtin_bit_cast(int, f) & ~clr) | idx); }
__device__ __forceinline__ int keyidx(float k, int m) { return __builtin_bit_cast(int, k) & m; }
__device__ __forceinline__ unsigned tab16(const unsigned (&T)[4], int a) {
    const unsigned sel = (unsigned)(a & 7);
    const unsigned x = __builtin_amdgcn_perm(T[1], T[0], sel), y = __builtin_amdgcn_perm(T[3], T[2], sel);
    return ((a & 8) ? y : x) & 255u;
}
constexpr int TK_KP = 272;
__device__ __forceinline__ void topk_half(const LAS unsigned char* kl, const bf16x8 (&qf)[8], int hi, int l31, float (&out)[16], float kpi, float kni) {
    f32x16 acc[4] = {};
    const LAS unsigned char* kp = kl + l31 * TK_KP + hi * 16;
    bf16x8 kfa[4], kfb[4];
#pragma unroll
    for (int kt = 0; kt < 4; ++kt) kfa[kt] = *(const LAS bf16x8*)(kp + kt * 32 * TK_KP);
#pragma unroll
    for (int s = 0; s < 8; s += 2) {
#pragma unroll
        for (int kt = 0; kt < 4; ++kt) kfb[kt] = *(const LAS bf16x8*)(kp + kt * 32 * TK_KP + 32 * (s + 1));
#pragma unroll
        for (int kt = 0; kt < 4; ++kt) acc[kt] = __builtin_amdgcn_mfma_f32_32x32x16_bf16(kfa[kt], qf[s], acc[kt], 0, 0, 0);
        if (s + 2 < 8) {
#pragma unroll
            for (int kt = 0; kt < 4; ++kt) kfa[kt] = *(const LAS bf16x8*)(kp + kt * 32 * TK_KP + 32 * (s + 2)); }
#pragma unroll
        for (int kt = 0; kt < 4; ++kt) acc[kt] = __builtin_amdgcn_mfma_f32_32x32x16_bf16(kfb[kt], qf[s + 1], acc[kt], 0, 0, 0);
    }
    float v0[16], v1[16], v2[16], v3[16];
#pragma unroll
    for (int rr = 0; rr < 16; ++rr) { const int ib = 127 - (rr & 3) - 8 * (rr >> 2) - 4 * hi;
        v0[rr] = mkkey(acc[0][rr], 127, ib); v1[rr] = mkkey(acc[1][rr], 127, ib - 32); v2[rr] = mkkey(acc[2][rr], 127, ib - 64); v3[rr] = mkkey(acc[3][rr], 127, ib - 96); }
    sort16(v0, kpi, kni); sort16(v1, kpi, kni); sort16(v2, kpi, kni); sort16(v3, kpi, kni);
    topmerge16(v0, v1, kpi, kni); topmerge16(v2, v3, kpi, kni); topmerge16(v0, v2, kpi, kni);
#pragma unroll
    for (int i = 0; i < 16; ++i) v1[i] = xhalf_other(v0[i], hi);
    topmerge16(v0, v1, kpi, kni);
#pragma unroll
    for (int i = 0; i < 16; ++i) out[i] = v0[i];
    __builtin_amdgcn_sched_barrier(0);
}
#define TK_LOADQ(QF, ROW, P) { const bf16* qp_ = QP + (size_t)(ROW) * 2048 + h * 256 + (P) * 128 + 8 * hi; _Pragma("unroll") for (int s_ = 0; s_ < 8; ++s_) QF[s_] = *(const GAS bf16x8*)(qp_ + 16 * s_); }
__device__ __forceinline__ void ph_topk(const Args& a, int layer, int row_lo, LAS unsigned char* L, int tid, int lane, int wave, int vcu, int G) {
    unsigned char* ws = a.ws;
    const bf16* QP = (const bf16*)(ws + WS_P); unsigned short* eidx = (unsigned short*)(ws + WS_EIDX); float* egate = (float*)(ws + WS_GATE);
    const int hi = lane >> 5, l31 = lane & 31, h = vcu & 7;
    const int nwh = (G - h + 7) >> 3;
    { const bf16* KEYS = (const bf16*)(ws + WS_KEYS) + ((size_t)layer * 8 + h) * 2 * 128 * 128;
#pragma unroll
      for (int i = 0; i < 8; ++i) { const int idx = tid + 512 * i, row = idx >> 4, chn = idx & 15; *(LAS v4u*)(L + row * TK_KP + chn * 16) = *(const GAS v4u*)(KEYS + (size_t)row * 128 + chn * 8); }
      __syncthreads(); }
    const int ngroups = (R - row_lo) / 32, W = nwh * NWAVES, rounds = ngroups / W;
    int tailg = rounds * W + wave * nwh + (vcu >> 3); const int cnt = rounds + (tailg < ngroups ? 1 : 0);
    tailg -= rounds * W + (vcu >> 3) * NWAVES + wave;
#define TK_GRP(i) ((vcu >> 3) * NWAVES + wave + (i) * W + ((i) < rounds ? 0 : tailg))
    float kpi = __builtin_inff(), kni = -__builtin_inff(); asm volatile("" : "+s"(kpi), "+s"(kni));
    bf16x8 qa[8], qb[8];
    if (cnt > 0) TK_LOADQ(qa, row_lo + TK_GRP(0) * 32 + l31, 0)
#pragma unroll 1
    for (int gi = 0; gi < cnt; ++gi) {
        const int grp = TK_GRP(gi);
        const int r = row_lo + grp * 32 + l31;
        TK_LOADQ(qb, r, 1)
        float sv0[16], sv1[16];
        topk_half(L, qa, hi, l31, sv0, kpi, kni);
        { const int gn = gi + 1 < cnt ? TK_GRP(gi + 1) : grp; const int rn = row_lo + gn * 32 + l31; TK_LOADQ(qa, rn, 0) }
        topk_half(L + 128 * TK_KP, qb, hi, l31, sv1, kpi, kni);
#define CANDK(aa, bb) mkkey(sv0[aa] + sv1[bb], 255, 255 - ((aa) * 16 + (bb)))
        const float NEGINF = -__builtin_inff();
        float c0[16], c1[16], c2[16], c3[16];
#pragma unroll
        for (int i = 0; i < 16; ++i) { c0[i] = CANDK(0, i); c1[i] = i < 8 ? CANDK(1, (i & 7)) : NEGINF; }
        c2[0] = CANDK(2, 0); c2[1] = CANDK(2, 1); c2[2] = CANDK(2, 2); c2[3] = CANDK(2, 3); c2[4] = CANDK(2, 4); c2[5] = CANDK(3, 0); c2[6] = CANDK(3, 1); c2[7] = CANDK(3, 2); c2[8] = CANDK(3, 3);
        c2[9] = CANDK(4, 0); c2[10] = CANDK(4, 1); c2[11] = CANDK(4, 2); c2[12] = CANDK(5, 0); c2[13] = CANDK(5, 1); c2[14] = CANDK(6, 0); c2[15] = CANDK(6, 1);
        c3[0] = CANDK(7, 0); c3[1] = CANDK(7, 1); c3[2] = CANDK(8, 0); c3[3] = CANDK(9, 0); c3[4] = CANDK(10, 0); c3[5] = CANDK(11, 0); c3[6] = CANDK(12, 0); c3[7] = CANDK(13, 0); c3[8] = CANDK(14, 0); c3[9] = CANDK(15, 0);
#pragma unroll
        for (int i = 10; i < 16; ++i) c3[i] = NEGINF;
#undef CANDK
        sort16(c2, kpi, kni); sort16(c3, kpi, kni);
        topmerge16(c0, c1, kpi, kni); topmerge16(c2, c3, kpi, kni); topmerge16(c0, c2, kpi, kni);
        float fv[16]; float den = 0.f;
#pragma unroll
        for (int i = 0; i < 16; ++i) { fv[i] = __expf(c0[i] - c0[0]); den += fv[i]; }
        const float rden = 1.0f / den;
        unsigned T0[4], T1[4];
#pragma unroll
        for (int w = 0; w < 4; ++w) {
            T0[w] = (unsigned)(127 - keyidx(sv0[4 * w], 127)) | ((unsigned)(127 - keyidx(sv0[4 * w + 1], 127)) << 8) | ((unsigned)(127 - keyidx(sv0[4 * w + 2], 127)) << 16) | ((unsigned)(127 - keyidx(sv0[4 * w + 3], 127)) << 24);
            T1[w] = (unsigned)(127 - keyidx(sv1[4 * w], 127)) | ((unsigned)(127 - keyidx(sv1[4 * w + 1], 127)) << 8) | ((unsigned)(127 - keyidx(sv1[4 * w + 2], 127)) << 16) | ((unsigned)(127 - keyidx(sv1[4 * w + 3], 127)) << 24);
        }
        int ev[8]; float gv[8];
#pragma unroll
        for (int i = 0; i < 8; ++i) { float ca = c0[i], cb = c0[8 + i]; float fa = fv[i], fb = fv[8 + i];
            asm volatile("" : "+v"(ca), "+v"(cb), "+v"(fa), "+v"(fb));
            const int ck = __builtin_bit_cast(int, hi ? cb : ca); const int id = 255 - (ck & 255);
            ev[i] = (int)(tab16(T0, id >> 4) * 128u + tab16(T1, id & 15)); gv[i] = (hi ? fb : fa) * rden; }
        unsigned short* ep = eidx + (size_t)r * 128 + h * 16 + 8 * hi; float* gp = egate + (size_t)r * 128 + h * 16 + 8 * hi;
        *(GAS v4u*)ep = (v4u){(unsigned)ev[0] | ((unsigned)ev[1] << 16), (unsigned)ev[2] | ((unsigned)ev[3] << 16), (unsigned)ev[4] | ((unsigned)ev[5] << 16), (unsigned)ev[6] | ((unsigned)ev[7] << 16)};
        *(GAS f32x4*)gp = (f32x4){gv[0], gv[1], gv[2], gv[3]}; *(GAS f32x4*)(gp + 4) = (f32x4){gv[4], gv[5], gv[6], gv[7]};
    }
}
struct XInfo { int pj, nx, nloc, rank; };
typedef float f32x2v __attribute__((ext_vector_type(2)));
__device__ __forceinline__ int red8_i(int v) { v += dpp_i<0xB1>(v); v += dpp_i<0x4E>(v); v += dpp_i<0x141>(v); return v; }
__device__ __forceinline__ unsigned id_of(const v4u& id0, const v4u& id1, int i) { const unsigned w = (i < 8 ? id0 : id1)[(i & 7) >> 1]; return (i & 1) ? (w >> 16) : (w & 0xffffu); }

#define PU_LOAD_RAW(T, IW, HW) { const int t_ = (T) < R ? (T) : row_lo; IW = *(const GAS unsigned*)(E + (size_t)t_ * 128 + 2 * lane); HW = *(const GAS unsigned*)(H8 + (size_t)t_ * D + s * 128 + 4 * (lane & 31)); }
#define PU_EXPAND(IW, HW, I0, I1, HQ) { _Pragma("unroll") for (int c = 0; c < 4; ++c) { I0[c] = (unsigned)__builtin_amdgcn_ds_bpermute(gb4 + 4 * c, (int)IW); I1[c] = (unsigned)__builtin_amdgcn_ds_bpermute(gb4 + 16 + 4 * c, (int)IW); \
    HQ[c] = (unsigned)__builtin_amdgcn_ds_bpermute(jb4 + 4 * c, (int)HW); } }
#ifdef EXP_SC1
#define PU_LOAD_ROWS(ROW, I0, I1) { _Pragma("unroll") for (int i = 0; i < 16; ++i) ROW[i] = __builtin_bit_cast(v4u, __builtin_amdgcn_raw_buffer_load_b128(trs, (int)(id_of(I0, I1, i) * 128u + joff), 0, EXP_SC1)); }
#else
#define PU_LOAD_ROWS(ROW, I0, I1) { _Pragma("unroll") for (int i = 0; i < 16; ++i) ROW[i] = *(const GAS v4u*)(tus + (id_of(I0, I1, i) * 128u + joff)); }
#endif
#define PU_COMPUTE(T, ROW, HQ) { int res[16]; \
    _Pragma("unroll") for (int i = 0; i < 16; ++i) { int d = __builtin_amdgcn_sdot4((int)ROW[i].x, (int)HQ.x, 0, false); d = __builtin_amdgcn_sdot4((int)ROW[i].y, (int)HQ.y, d, false); \
        d = __builtin_amdgcn_sdot4((int)ROW[i].z, (int)HQ.z, d, false); d = __builtin_amdgcn_sdot4((int)ROW[i].w, (int)HQ.w, d, false); res[i] = red8_i(d); } \
      \
      \
    int lo_, hi_; { int r0 = res[0], r1 = res[1], r2 = res[2], r3 = res[3], r4 = res[4], r5 = res[5], r6 = res[6], r7 = res[7], r8 = res[8], r9 = res[9], r10 = res[10], r11 = res[11], r12 = res[12], r13 = res[13], r14 = res[14], r15 = res[15]; \
      asm volatile("" : "+v"(r0), "+v"(r1), "+v"(r2), "+v"(r3), "+v"(r4), "+v"(r5), "+v"(r6), "+v"(r7), "+v"(r8), "+v"(r9), "+v"(r10), "+v"(r11), "+v"(r12), "+v"(r13), "+v"(r14), "+v"(r15)); \
      const int a00 = jb0 ? r2 : r0, a01 = jb0 ? r3 : r1, a10 = jb0 ? r6 : r4, a11 = jb0 ? r7 : r5, a20 = jb0 ? r10 : r8, a21 = jb0 ? r11 : r9, a30 = jb0 ? r14 : r12, a31 = jb0 ? r15 : r13; \
      const int b00 = jb1 ? a10 : a00, b01 = jb1 ? a11 : a01, b10 = jb1 ? a30 : a20, b11 = jb1 ? a31 : a21; \
      lo_ = jb2 ? b10 : b00; hi_ = jb2 ? b11 : b01; }     \
    *(GAS unsigned*)(PART + ((size_t)s * R + (T)) * 64 + lane) = __builtin_bit_cast(unsigned, __builtin_amdgcn_cvt_pkrtz((float)lo_ * 0.015625f, (float)hi_ * 0.015625f)); }
__device__ __forceinline__ void ph_peer_u(const Args& a, int layer, int row_lo, const XInfo xi, int lane, int wave) {
    unsigned char* ws = a.ws;
    const unsigned short* E = (const unsigned short*)(ws + WS_EIDX); const unsigned char* TU = ws + WS_TABU + (size_t)layer * NEXP * D; const unsigned char* H8 = ws + WS_H8;
    unsigned* PART = (unsigned*)(ws + WS_PART);
#ifdef EXP_HALFCU
    if (xi.rank & 1) return;
    const int g = lane >> 3, j = lane & 7, st = (xi.nloc / 2) * NWAVES; const int rank_ = xi.rank >> 1;
#else
    const int g = lane >> 3, j = lane & 7, st = xi.nloc * NWAVES; const int rank_ = xi.rank;
#endif
    const int gb4 = (lane & ~7) << 2, jb4 = j << 4;
    const bool jb0 = (j & 1) != 0, jb1 = (j & 2) != 0, jb2 = (j & 4) != 0;
    for (int s = xi.pj; s < 8; s += xi.nx) {
        const unsigned char* tus = TU + (size_t)s * (NEXP * 128); const unsigned joff = (unsigned)j * 16u;
#ifdef EXP_SC1
        const __amdgpu_buffer_rsrc_t trs = __builtin_amdgcn_make_buffer_rsrc((void*)tus, 0, NEXP * 128, 0x00020000);
#endif
        int t = row_lo + rank_ * NWAVES + wave;
        if (t >= R) continue;
        v4u ia0, ia1, ha, ib0, ib1, hb, rowA[16], rowB[16]; unsigned wa, xa, wb, xb;
        PU_LOAD_RAW(t, wa, xa) PU_LOAD_RAW(t + st, wb, xb)
        PU_EXPAND(wa, xa, ia0, ia1, ha)
        PU_LOAD_ROWS(rowA, ia0, ia1)
        PU_LOAD_RAW(t + 2 * st, wa, xa)
#pragma unroll 1
        for (; t < R; t += 2 * st) {
            PU_EXPAND(wb, xb, ib0, ib1, hb)
            PU_LOAD_ROWS(rowB, ib0, ib1)
            PU_LOAD_RAW(t + 3 * st, wb, xb)
            asm volatile("" ::: "memory");
            PU_COMPUTE(t, rowA, ha)
            if (t + st < R) {
                PU_EXPAND(wa, xa, ia0, ia1, ha)
                PU_LOAD_ROWS(rowA, ia0, ia1)
                PU_LOAD_RAW(t + 4 * st, wa, xa)
                asm volatile("" ::: "memory");
                PU_COMPUTE(t + st, rowB, hb)
            }
        }
    }
}
__device__ __forceinline__ void ph_peer_c(const Args& a, int layer, int row_lo, LAS unsigned char* L, int tid, int lane, int gw, int NGW) {
    unsigned char* ws = a.ws;
    const unsigned short* E = (const unsigned short*)(ws + WS_EIDX); const float* egate = (const float*)(ws + WS_GATE); const unsigned short* PART = (const unsigned short*)(ws + WS_PART);
    const float* SU = (const float*)(ws + WS_SCALE) + (size_t)layer * NEXP; const float* SV = (const float*)(ws + WS_SCALE) + (size_t)(2 + layer) * NEXP;
    const float* hsc = (const float*)(ws + WS_HSC); signed char* COEF = (signed char*)(ws + WS_COEF); float* CSC = (float*)(ws + WS_CSUM);
    { LAS v4u* Ls = (LAS v4u*)L;
#pragma unroll
      for (int i = 0; i < 8; ++i) { Ls[tid + 512 * i] = *(const GAS v4u*)(SU + 4 * (tid + 512 * i)); Ls[4096 + tid + 512 * i] = *(const GAS v4u*)(SV + 4 * (tid + 512 * i)); }
      __syncthreads(); }
    const LAS float* SUl = (const LAS float*)L; const LAS float* SVl = SUl + NEXP;
    constexpr int CR = 6;
    for (int t0 = row_lo + gw; t0 < R; t0 += CR * NGW) {
        float S[CR][2]; int e[CR][2]; float gt[CR][2], hs[CR], su[CR][2], sv[CR][2];
#pragma unroll
        for (int q = 0; q < CR; ++q) { const int t = t0 + q * NGW < R ? t0 + q * NGW : t0; hs[q] = hsc[t];
            float a0 = 0.f, a1 = 0.f;
#pragma unroll
            for (int sl = 0; sl < 8; ++sl) { typedef _Float16 h2_t __attribute__((ext_vector_type(2)));
                const h2_t w = __builtin_bit_cast(h2_t, *(const GAS unsigned*)(PART + ((size_t)sl * R + t) * 128 + 2 * lane)); a0 += (float)w[0]; a1 += (float)w[1]; }
            S[q][0] = a0 * 64.0f; S[q][1] = a1 * 64.0f;
            const unsigned ew = *(const GAS unsigned*)(E + (size_t)t * 128 + 2 * lane); e[q][0] = (int)(ew & 0xffffu); e[q][1] = (int)(ew >> 16);
            const f32x2v gw2 = *(const f32x2v*)(egate + (size_t)t * 128 + 2 * lane); gt[q][0] = gw2.x; gt[q][1] = gw2.y; }
#pragma unroll
        for (int q = 0; q < CR; ++q)
#pragma unroll
            for (int hh = 0; hh < 2; ++hh) { su[q][hh] = SUl[e[q][hh]]; sv[q][hh] = SVl[e[q][hh]]; }
#pragma unroll
        for (int q = 0; q < CR; ++q) { const int t = t0 + q * NGW; if (t < R) {
            float c[2];
#pragma unroll
            for (int hh = 0; hh < 2; ++hh) { float z = su[q][hh] * S[q][hh]; asm volatile("" : "+v"(z));
                z *= hs[q]; c[hh] = gelu_tanh(z) * gt[q][hh] * sv[q][hh]; }
            const float mx = fmaxf(wave_max(fmaxf(fabsf(c[0]), fabsf(c[1]))), 1e-30f), inv = 127.0f / mx;
            int q0 = (int)rintf(c[0] * inv), q1 = (int)rintf(c[1] * inv); q0 = q0 < -127 ? -127 : (q0 > 127 ? 127 : q0); q1 = q1 < -127 ? -127 : (q1 > 127 ? 127 : q1);
            *(GAS unsigned short*)(COEF + (size_t)t * 128 + 2 * lane) = (unsigned short)((q0 & 255) | ((q1 & 255) << 8));
            if (lane == 0) CSC[t] = mx * (1.0f / 127.0f); } }
    }
}
#define PV_BLOCK(r0, r1, r2, r3, cw, A0, A1, A2, A3) { \
    const unsigned pa_ = __builtin_amdgcn_perm(r1, r0, 0x05010400u), pb_ = __builtin_amdgcn_perm(r1, r0, 0x07030602u), pc_ = __builtin_amdgcn_perm(r3, r2, 0x05010400u), pd_ = __builtin_amdgcn_perm(r3, r2, 0x07030602u); \
    A0 = __builtin_amdgcn_sdot4((int)__builtin_amdgcn_perm(pc_, pa_, 0x05040100u), (int)(cw), A0, false); A1 = __builtin_amdgcn_sdot4((int)__builtin_amdgcn_perm(pc_, pa_, 0x07060302u), (int)(cw), A1, false); \
    A2 = __builtin_amdgcn_sdot4((int)__builtin_amdgcn_perm(pd_, pb_, 0x05040100u), (int)(cw), A2, false); A3 = __builtin_amdgcn_sdot4((int)__builtin_amdgcn_perm(pd_, pb_, 0x07060302u), (int)(cw), A3, false); }
#define PV_LOAD_RAW(T, IW, CW) { const int t_ = (T) < R ? (T) : row_lo; IW = *(const GAS unsigned*)(E + (size_t)t_ * 128 + 2 * lane); CW = *(const GAS unsigned*)(lane < 32 ? (const unsigned char*)COEF + (size_t)t_ * 128 + 4 * lane : (const unsigned char*)(CSC + t_)); }
#define PV_EXPAND(IW, CW, I0, I1, CQ, CS) { CS = __builtin_bit_cast(float, __builtin_amdgcn_readlane((int)CW, 32)); _Pragma("unroll") for (int c = 0; c < 4; ++c) { I0[c] = (unsigned)__builtin_amdgcn_ds_bpermute(gb4 + 4 * c, (int)IW); I1[c] = (unsigned)__builtin_amdgcn_ds_bpermute(gb4 + 16 + 4 * c, (int)IW); \
    CQ[c] = (unsigned)__builtin_amdgcn_ds_bpermute(cb4 + 4 * c, (int)CW); } }
#define PV_LOAD_ROWS(ROW, I0, I1) { _Pragma("unroll") for (int i = 0; i < 16; ++i) ROW[i] = *(const GAS v4u*)(tvs + (id_of(I0, I1, i) * 128u + joff)); }
#define PV_COMPUTE(T, ROW, CQ, CS) { const int t_ = (T); \
    bf16* x = X + (size_t)t_ * D + s * 128 + j * 16 + 2 * g; { const int mb_ = row_modb(t_); if (mb_ != mbcur) { mbcur = mb_; gv = *(const f32x2v*)(modsL + (size_t)mb_ * NMOD + 5 * D + s * 128 + j * 16 + 2 * g); } }     \
    const unsigned xq_ = *(const GAS unsigned*)x; const float cs = (CS) * live; \
    int acc[16]; \
    _Pragma("unroll") for (int b = 0; b < 16; ++b) acc[b] = 0; \
    _Pragma("unroll") for (int m = 0; m < 4; ++m) _Pragma("unroll") for (int q = 0; q < 4; ++q) PV_BLOCK(ROW[4 * m][q], ROW[4 * m + 1][q], ROW[4 * m + 2][q], ROW[4 * m + 3][q], CQ[m], acc[4 * q], acc[4 * q + 1], acc[4 * q + 2], acc[4 * q + 3]) \
    int r8[8], r4[4]; \
    _Pragma("unroll") for (int b = 0; b < 8; ++b) { auto rr = __builtin_amdgcn_permlane32_swap((unsigned)acc[b], (unsigned)acc[b + 8], false, false); r8[b] = (int)(rr[0] + rr[1]); } \
    _Pragma("unroll") for (int c = 0; c < 4; ++c) { auto rr = __builtin_amdgcn_permlane16_swap((unsigned)r8[c], (unsigned)r8[c + 4], false, false); r4[c] = (int)(rr[0] + rr[1]); } \
    const bool up_ = (lane & 8) != 0; \
    const int o0_ = (up_ ? r4[2] : r4[0]) + dpp_i<0x128>(up_ ? r4[0] : r4[2]), o1_ = (up_ ? r4[3] : r4[1]) + dpp_i<0x128>(up_ ? r4[1] : r4[3]); \
    const float x0_ = bflo(xq_) + gv.x * (cs * (float)o0_), x1_ = bfhi(xq_) + gv.y * (cs * (float)o1_); *(GAS unsigned*)x = pk2(x0_, x1_); }
__device__ __forceinline__ void ph_peer_v(const Args& a, int layer, int row_lo, const XInfo xi, int lane, int wave, float live) {
    unsigned char* ws = a.ws;
    const unsigned short* E = (const unsigned short*)(ws + WS_EIDX); const unsigned char* TV = ws + WS_TABV + (size_t)layer * NEXP * D;
    const signed char* COEF = (const signed char*)(ws + WS_COEF); const float* CSC = (const float*)(ws + WS_CSUM);
    const float* modsL = (const float*)(ws + WS_MODS) + (size_t)layer * 5 * NMOD;
    bf16* X = (bf16*)(ws + WS_X);
    const int g = lane >> 3, j = lane & 7, st = xi.nloc * NWAVES;
    const int gb4 = (lane & ~7) << 2, cb4 = g << 4;
    for (int s = xi.pj; s < 8; s += xi.nx) {
        const unsigned char* tvs = TV + (size_t)s * (NEXP * 128); const unsigned joff = (unsigned)j * 16u;
        int t = row_lo + xi.rank * NWAVES + wave;
        if (t >= R) continue;
        v4u ia0, ia1, ca, ib0, ib1, cb, rowA[16], rowB[16]; unsigned wa, xa, wb, xb;
        int mbcur = -1; f32x2v gv = {0.f, 0.f}; float csa, csb;
        PV_LOAD_RAW(t, wa, xa) PV_LOAD_RAW(t + st, wb, xb)
        PV_EXPAND(wa, xa, ia0, ia1, ca, csa)
        PV_LOAD_ROWS(rowA, ia0, ia1)
        PV_LOAD_RAW(t + 2 * st, wa, xa)
#pragma unroll 1
        for (; t < R; t += 2 * st) {
            PV_EXPAND(wb, xb, ib0, ib1, cb, csb)
            PV_LOAD_ROWS(rowB, ib0, ib1)
            PV_LOAD_RAW(t + 3 * st, wb, xb)
            asm volatile("" ::: "memory");
            PV_COMPUTE(t, rowA, ca, csa)
            if (t + st < R) {
                PV_EXPAND(wa, xa, ia0, ia1, ca, csa)
                PV_LOAD_ROWS(rowA, ia0, ia1)
                PV_LOAD_RAW(t + 4 * st, wa, xa)
                asm volatile("" ::: "memory");
                PV_COMPUTE(t + st, rowB, cb, csb)
            }
        }
    }
}
constexpr int NSUB = 11;
constexpr int N_PHASES = 2 + NSUB * DEPTH;
__global__ void __launch_bounds__(NWAVES * 64, 2) mk_fwd(Args a) {
    extern __shared__ __attribute__((aligned(16))) unsigned char lds[];
    LAS unsigned char* L = (LAS unsigned char*)lds;
    volatile LAS unsigned* MISC = (volatile LAS unsigned*)(L + MISC_OFF);
    const int G = gridDim.x; const int bx = blockIdx.x; const int vcu = (G % 8 == 0) ? (bx % 8) * (G / 8) + bx / 8 : bx;
    const int NGW = G * NWAVES;
    unsigned char* ws = a.ws;
    for (int u = threadIdx.x; u < 512 / 4; u += NWAVES * 64) ((LAS unsigned*)(L + MISC_OFF))[u] = 0u;
    __syncthreads();
    const int wave0 = __builtin_amdgcn_readfirstlane((int)threadIdx.x >> 6);
    const bool multi = (a.ph_hi - a.ph_lo) > 1;
    XcdBarrier bar; bar.bar = (unsigned*)(ws + WS_CTL) + CW_BAR; bar.x = 0; bar.st = nullptr;
    if (multi) bar = xcd_barrier_post((unsigned*)(ws + WS_CTL) + CW_BAR, MISC + 8);
    if (threadIdx.x == 0) MISC[16] = xb_add((unsigned*)(ws + WS_CTL) + CW_RANK + 64 * xb_xcc_id(), 1u);
const int ph_lo_ = a.ph_lo, ph_hi_ = a.ph_hi;
#pragma unroll 1
#ifdef EXP_NOH8
#define EXPH8 ((phx % (REP_N + 1)) != 0)
#else
#define EXPH8 false
#endif
#ifndef REP_PH
#define REP_PH -1
#define REP_N 0
#endif
    for (int phx = ph_lo_ * (REP_N + 1); phx < ph_hi_ * (REP_N + 1); ++phx) {
        int ph = phx / (REP_N + 1);
        if (ph != REP_PH && (phx % (REP_N + 1)) != 0) continue;
        unsigned char* ws = a.ws; asm volatile("" : "+s"(ws));
        const float* mods = (const float*)(ws + WS_MODS);
        bf16* XN = (bf16*)(ws + WS_XN); bf16* P = (bf16*)(ws + WS_P); bf16* Y = (bf16*)(ws + WS_Y);
        bf16* X = (bf16*)(ws + WS_X);
#define TID (lane_now() + wave0 * 64)
#define LANE lane_now()
        const int wave = wave0, gw = vcu * NWAVES + wave0;
#ifdef ONLY_SUB
#define SUBON(x) ((x) == ONLY_SUB)
#else
#define SUBON(x) true
#endif
#ifdef EXP_EMPTY
        if ((phx % (REP_N + 1)) != 0) {} else
#endif
        if (ph == 0 && SUBON(100)) ph_prologue(a, L, TID, LANE, wave, vcu, G);
        else if (ph == 1 && SUBON(101)) ph_norm(a.in[I_CTX], a.in[I_X], nullptr, a.in[I_N1G], mods, 0, 1, XN, nullptr, nullptr, 0, gw, NGW, LANE);
        else {
            const int layer = (ph - 2) / NSUB, sub = (ph - 2) % NSUB; const bool last = layer == DEPTH - 1;
            const float* modsL = mods + (size_t)layer * 5 * NMOD;
            const int rlo2 = last ? R_CTX : 0;
            if (sub == 0 && SUBON(0)) {
                const bf16* Wt = (const bf16*)(ws + WS_WIN) + (size_t)layer * D_IN * D;
                { pg8::Gemm g{XN, Wt, R_CTX, D_IN, D}; pg8::EpiBf16<0> E{P, D_IN, nullptr, 0, 0, 1.f, 128, 1};
                  pg8::OrderHalf S; S.init(R_CTX / 128, last ? 1 : 8, last ? 7 : 0, G, bx); pg8::gemm_phase<pg8::EpiBf16<0>, pg8::OrderHalf, true, true, true>(L, g, S, E, TID); }
                { pg8::Gemm g{XN + (size_t)R_CTX * D, Wt, R_LAT, D_IN, D}; pg8::EpiBf16<0> E{P + (size_t)R_CTX * D_IN, D_IN, nullptr, 0, 0, 1.f};
#ifdef EXP_NOSTORE
                  if ((phx % (REP_N + 1)) != 0) E.nai = 0;
#endif
                  pg8::StaticOrder S; S.init(R_LAT, D_IN, G, bx); pg8::gemm_phase<pg8::EpiBf16<0>, pg8::StaticOrder, true, true>(L, g, S, E, TID); }
                if (layer == 0) tail_quant(a, ws, 0, bx, G, wave, LANE);
            } else if (sub == 1 && SUBON(1)) ph_post(a, layer, last, L, TID, LANE, wave, vcu, G);
            else if (sub == 2 && SUBON(2)) { ph_attn(a, layer, last, L, TID, LANE, wave, vcu, G);
#ifdef EXP_EDGE
                __syncthreads(); ph_attn_simple(a, layer, rlo2, L, LANE, wave, gw, NGW);
#endif
            }
            else if (sub == 3 && SUBON(3)) {
                const bf16* Wt = (const bf16*)(ws + WS_WOUT) + (size_t)layer * D * D;
                { pg8::Gemm g{Y + (size_t)R_CTX * D, Wt, R_LAT, D, D}; pg8::StaticOrder S; S.init(R_LAT, D, G, bx);
                  if (layer == 0) { pg8::EpiResid<true> E{a.in[I_CTX], a.in[I_X], X, modsL + 2 * D, (const float*)(ws + WS_SSQ), (LAS float*)(L + 131072), R_CTX};
                      pg8::gemm_phase<pg8::EpiResid<true>, pg8::StaticOrder, true, true>(L, g, S, E, TID); }
                  else { pg8::EpiResid<false> E{nullptr, nullptr, X, modsL + 2 * D, (const float*)(ws + WS_SSQ), (LAS float*)(L + 131072), R_CTX};
                      pg8::gemm_phase<pg8::EpiResid<false>, pg8::StaticOrder, true, true>(L, g, S, E, TID); } }
                if (layer == 0) { pg8::Gemm g{Y, Wt, R_CTX, D, D}; pg8::OrderHalf S; S.init(R_CTX / 128, 4, 0, G, bx);
                    pg8::EpiResid<true> E{a.in[I_CTX], a.in[I_X], X, modsL + 2 * D, (const float*)(ws + WS_SSQ), (LAS float*)(L + 131072), 0, 128, 1};
                    pg8::gemm_phase<pg8::EpiResid<true>, pg8::OrderHalf, true, true, true>(L, g, S, E, TID);
                    tail_quant(a, ws, 1, bx, G, wave, LANE); }
            } else if (sub == 4 && SUBON(4)) ph_norm(nullptr, nullptr, X, a.in[I_N2G] + layer * D, modsL, 3, 4, XN, (signed char*)(ws + WS_H8), (float*)(ws + WS_HSC), rlo2, gw, NGW, LANE);
            else if (sub == 5 && SUBON(5)) {
                const bf16* Wt = (const bf16*)(ws + WS_WQ) + (size_t)layer * 2048 * D;
                if (layer == 0) { pg8::Gemm g{XN, Wt, R_CTX, 2048, D}; pg8::OrderHalf S; S.init(R_CTX / 128, 8, 0, G, bx);
                    pg8::EpiBf16<0> E{P, 2048, nullptr, 0, 0, 1.f, 128, 1};
                    pg8::gemm_phase<pg8::EpiBf16<0>, pg8::OrderHalf, true, true, true>(L, g, S, E, TID); }
                { pg8::Gemm g{XN + (size_t)R_CTX * D, Wt, R_LAT, 2048, D}; pg8::StaticOrder S; S.init(R_LAT, 2048, G, bx);
                  pg8::EpiBf16<0> E{P + (size_t)R_CTX * 2048, 2048, nullptr, 0, 0, 1.f};
                  pg8::gemm_phase<pg8::EpiBf16<0>, pg8::StaticOrder, true, true>(L, g, S, E, TID); }
                if (layer == 0) { tail_quant(a, ws, 2, bx, G, wave, LANE); }
            } else if (sub == 6 && SUBON(6)) ph_topk(a, layer, rlo2, L, TID, LANE, wave, vcu, G);
            else if (sub >= 7 && sub <= 9 && SUBON(7)) {
                if (TID == 0) { unsigned pj = 0, nx = 0, nloc = 1; const unsigned myx = xb_xcc_id();
                    for (unsigned jx = 0; jx < 16; ++jx) { const unsigned c = xb_ld((unsigned*)(ws + WS_CTL) + CW_BAR + XB_XCNT(jx)); if (c) { if (jx < myx) ++pj; ++nx; if (jx == myx) nloc = c; } }
                    MISC[17] = pj; MISC[18] = nx ? nx : 1; MISC[19] = nloc; }
                __syncthreads();
                XInfo xi; xi.pj = (int)MISC[17]; xi.nx = (int)MISC[18]; xi.nloc = (int)MISC[19]; xi.rank = (int)MISC[16];
                if (sub == 7) ph_peer_u(a, layer, rlo2, xi, LANE, wave);
                else if (sub == 8) ph_peer_c(a, layer, rlo2, L, TID, LANE, gw, NGW);
                else ph_peer_v(a, layer, rlo2, xi, LANE, wave, (phx % (REP_N + 1)) == 0 ? 1.0f : 0.0f);
            } else if (sub == 10 && SUBON(10)) {
                if (!last) ph_norm(nullptr, nullptr, X, a.in[I_N1G] + (layer + 1) * D, mods + (size_t)(layer + 1) * 5 * NMOD, 0, 1, XN, nullptr, nullptr, 0, gw, NGW, LANE);
                else ph_final(X, a.out, a.in[I_FING], gw, NGW, LANE);
            }
        }
        if (phx + 1 < ph_hi_ * (REP_N + 1)) { int tb; asm volatile("v_mbcnt_lo_u32_b32 %0, -1, 0\n\tv_mbcnt_hi_u32_b32 %0, -1, %0" : "=v"(tb)); xcd_barrier(bar, tb + wave0 * 64); }
    }
}


#ifndef MK_PER_PHASE
#define MK_PER_PHASE 0
#endif
extern "C" void kernel_launch(void* const* d_in, const int* in_sizes, int n_in, void* d_out, int out_size, void* d_ws, size_t ws_size, hipStream_t stream) {
    static int grid = 0;
    if (grid == 0) {
        if (n_in != 21 || ws_size < WS_END) { fprintf(stderr, "kernel_launch: bad inputs (n_in %d, ws %zu)\n", n_in, ws_size); grid = -1; return; }
        int dev = 0, cus = 0;
        if (hipGetDevice(&dev) != hipSuccess || hipDeviceGetAttribute(&cus, hipDeviceAttributeMultiprocessorCount, dev) != hipSuccess) { grid = -1; return; }
        if (hipFuncSetAttribute((const void*)mk_fwd, hipFuncAttributeMaxDynamicSharedMemorySize, LDS_BYTES) != hipSuccess) { fprintf(stderr, "kernel_launch: hipFuncSetAttribute failed\n"); grid = -1; return; }
        grid = cus;
    }
    if (grid < 0) return;
    (void)hipMemsetAsync((char*)d_ws + WS_CTL, 0, CTL_ZERO_BYTES, stream);
    Args a{};
    for (int i = 0; i < 21; ++i) a.in[i] = (const float*)d_in[i];
    a.out = (float*)d_out; a.ws = (unsigned char*)d_ws;
#if MK_PER_PHASE
    for (int ph = 0; ph < N_PHASES; ++ph) { a.ph_lo = ph; a.ph_hi = ph + 1; hipLaunchKernelGGL(mk_fwd, dim3(grid), dim3(NWAVES * 64), LDS_BYTES, stream, a); }
#else
    a.ph_lo = 0; a.ph_hi = N_PHASES; hipLaunchKernelGGL(mk_fwd, dim3(grid), dim3(NWAVES * 64), LDS_BYTES, stream, a);
#endif
}
```

```cpp
#include <hip/hip_runtime.h>
#include <cstdio>
#include <cstdint>
#include <cmath>
namespace pg8 {
#define PG8_LAS __attribute__((address_space(3)))
#define PG8_GAS __attribute__((address_space(1)))
typedef unsigned short bf16_t;
typedef short bf16x8 __attribute__((ext_vector_type(8)));
typedef float f32x4 __attribute__((ext_vector_type(4)));
typedef unsigned u32x4 __attribute__((ext_vector_type(4)));
typedef int i32x4 __attribute__((ext_vector_type(4)));
constexpr int BM = 256, BK = 64, HALF = 128, HTB = HALF * BK * 2  , STAGE_BYTES = 8 * HTB, NXCD = 8, WGM = 8;

__host__ __device__ __forceinline__ int lds_byte(int r, int c) { const int st = (r >> 4) * 2 + (c >> 5), rr = r & 15, cc = c & 31, ob = rr * 64 + cc * 2; return st * 1024 + (ob ^ (((ob >> 9) & 1) << 5)); }
__host__ __device__ __forceinline__ void stage_rc(int b, int& R, int& C) { const int st = b / 1024, sb = b % 1024, swz = sb ^ (((sb >> 9) & 1) << 5); R = (st >> 1) * 16 + swz / 64; C = (st & 1) * 32 + (swz % 64) / 2; }
__host__ __device__ __forceinline__ int perm32(int rho) { const int n = rho >> 4, i = rho & 15; return 8 * (i >> 2) + 4 * n + (i & 3); }

struct Unit { int pm, pn; };
struct Gemm { const bf16_t* A; const bf16_t* Bt; int M, N, K; };

struct StaticOrder {
    int nM, nN, nwg, G, c;
    __host__ __device__ void init(int M, int N, int G_, int c_) { nM = M / BM; nN = N / BM; nwg = nM * nN; G = G_; c = c_; }
    __host__ __device__ bool next(int i, Unit& u) const {
        const long L = (long)i * G + c; if (L >= nwg) return false;
        int wgid = (int)L; { const int q = nwg / NXCD, r = nwg % NXCD, xcd = wgid % NXCD, off = wgid / NXCD; wgid = (xcd < r ? xcd * (q + 1) : r * (q + 1) + (xcd - r) * q) + off; }
        const int nig = WGM * nN, gid = wgid / nig, fm = gid * WGM, gsz = (nM - fm) < WGM ? (nM - fm) : WGM;
        u.pm = fm + ((wgid % nig) % gsz); u.pn = (wgid % nig) / gsz; return true;
    }
    __device__ __forceinline__ void a_ready(const Unit&) const {}
    __device__ __forceinline__ void done(const Unit&) const {}
};

__device__ __forceinline__ unsigned cvt_pk_bf16(float lo, float hi) { unsigned r; asm volatile("v_cvt_pk_bf16_f32 %0, %1, %2" : "=v"(r) : "v"(lo), "v"(hi)); return r; }
typedef float f32x2 __attribute__((ext_vector_type(2)));
__device__ __forceinline__ f32x2 gelu_pk(f32x2 v) {
    const f32x2 av = __builtin_elementwise_abs(v), d = av * 0.2316418882f + 1.0f;
    f32x2 t; t.x = __builtin_amdgcn_rcpf(d.x); t.y = __builtin_amdgcn_rcpf(d.y);
    f32x2 q = t * 0.5307027145f + (-0.7265760135f); q = q * t + 0.7107068705f; q = q * t + (-0.142248368f); q = q * t + 0.127414796f; q = q * t;
    const f32x2 s = (v * v) * (-0.72134752044f);
    f32x2 e; e.x = __builtin_amdgcn_exp2f(s.x); e.y = __builtin_amdgcn_exp2f(s.y);
    const f32x2 m = v * (q * e), r = v - m;
    f32x2 o; o.x = v.x < 0.f ? m.x : r.x; o.y = v.y < 0.f ? m.y : r.y; return o;
}

template <int ACT  > struct EpiBf16 {
    static constexpr bool PERM = true, AFTER_DRAIN = false, HAS_MID = false; static_assert(ACT == 0 || ACT == 1, "EpiBf16: ACT is 0 (none) or 1 (gelu_pk)");
    bf16_t* O; int ldc; const float* bias; int split_cols; size_t split_stride; float scale0; int rpm = BM, nai = 2, fragrow = -1;
    __device__ __forceinline__ void operator()(const f32x4 (&acc)[2][2][4][2], const Unit& u, int wr, int wc, int fr, int fq) const {
        const int row0 = u.pm * rpm + wr * 64 + fr; int colt = u.pn * BM; bf16_t* base = O;
        float sc = 1.f; if (split_cols) { const int t = colt / split_cols; base += (size_t)t * split_stride; colt -= t * split_cols; if (t == 0) sc = scale0; }
        const int col0 = colt + wc * 32 + 8 * fq, bcol0 = u.pn * BM + wc * 32 + 8 * fq;
        f32x4 bv[2][2];
#pragma unroll
        for (int bj = 0; bj < 2; ++bj)
#pragma unroll
            for (int n = 0; n < 2; ++n) bv[bj][n] = bias ? *(const f32x4*)(bias + bcol0 + bj * HALF + 4 * n) : (f32x4){0.f, 0.f, 0.f, 0.f};
#pragma unroll
        for (int ai = 0; ai < 2; ++ai) if (ai < nai)
#pragma unroll
            for (int m = 0; m < 4; ++m) { bf16_t* rowp = base + (size_t)(row0 + ai * HALF + m * 16) * ldc + col0;
                if (fragrow >= 0) { const int ra = fragrow + row0 + ai * HALF + m * 16, c8 = 4 * wc + fq;
                    rowp = O + ((size_t)((ra >> 5) * 8 + u.pn) * 2) * 4096 + ((c8 >> 1) * 64 + (c8 & 1) * 32 + (ra & 31)) * 8; }
#pragma unroll
                for (int bj = 0; bj < 2; ++bj) { f32x4 v0 = acc[ai][bj][m][0] + bv[bj][0], v1 = acc[ai][bj][m][1] + bv[bj][1];
                    if (ACT == 1) { f32x2 a = gelu_pk((f32x2){v0[0], v0[1]}), b = gelu_pk((f32x2){v0[2], v0[3]}), c = gelu_pk((f32x2){v1[0], v1[1]}), d = gelu_pk((f32x2){v1[2], v1[3]});
                        v0 = (f32x4){a.x, a.y, b.x, b.y}; v1 = (f32x4){c.x, c.y, d.x, d.y}; }
                    v0 = v0 * sc; v1 = v1 * sc; u32x4 w; w.x = cvt_pk_bf16(v0[0], v0[1]); w.y = cvt_pk_bf16(v0[2], v0[3]); w.z = cvt_pk_bf16(v1[0], v1[1]); w.w = cvt_pk_bf16(v1[2], v1[3]);
                    *(PG8_GAS u32x4*)(rowp + (fragrow >= 0 ? bj * 4096 : bj * HALF)) = w; } }
    }
};
template <bool BASE_F32> struct EpiResid {
    static constexpr bool PERM = true, AFTER_DRAIN = false, HAS_MID = true;
    const float* base_c; const float* base_l;
    bf16_t* X;
    const float* gate;
    const float* ssq;
    PG8_LAS float* tab;
    int row_off; int rpm = BM, nai = 2;
    __device__ __forceinline__ void pre(const Unit& u, int wr, int wc, int fr, int fq) const {
        const int lane = fq * 16 + fr; PG8_LAS float* tw = tab + (wr * 4 + wc) * 128;
#pragma unroll
        for (int ai = 0; ai < 2; ++ai) { const int r = row_off + u.pm * rpm + ai * HALF + wr * 64 + lane;
            const f32x4 s0 = *(const PG8_GAS f32x4*)(ssq + (size_t)r * 8), s1 = *(const PG8_GAS f32x4*)(ssq + (size_t)r * 8 + 4);
            tw[ai * 64 + lane] = __builtin_amdgcn_sqrtf(((s0[0] + s0[1]) + (s0[2] + s0[3]) + (s1[0] + s1[1]) + (s1[2] + s1[3])) * (1.0f / 512.0f) + 1e-6f); }
        asm volatile("s_waitcnt lgkmcnt(0)" ::: "memory");
    }
    __device__ __forceinline__ void mid(f32x4 (&acc)[2][2][4][2], const Unit& u, int wr, int wc, int fr, int fq) const {
        const PG8_LAS float* tw = tab + (wr * 4 + wc) * 128;
#pragma unroll
        for (int ai = 0; ai < 2; ++ai)
#pragma unroll
            for (int m = 0; m < 4; ++m) { const float inv = tw[ai * 64 + m * 16 + fr];
#pragma unroll
                for (int bj = 0; bj < 2; ++bj)
#pragma unroll
                    for (int n = 0; n < 2; ++n) acc[ai][bj][m][n] *= inv; }
    }
    __device__ __forceinline__ void operator()(const f32x4 (&acc)[2][2][4][2], const Unit& u, int wr, int wc, int fr, int fq) const {
        const int rt = row_off + u.pm * rpm;
        const bool isc = rt < 1024; const int mb = isc ? 4 : ((rt - 1024) >> 13);
        const int col0 = u.pn * BM + wc * 32 + 8 * fq; const PG8_LAS float* tw = tab + (wr * 4 + wc) * 128;
        const float* gp = gate + (size_t)mb * 6144 + col0;
        const float* srcf = isc ? base_c + (size_t)rt * 1024 : base_l + (size_t)(rt - 1024) * 1024;
        const PG8_GAS unsigned char* srcb = (const PG8_GAS unsigned char*)srcf; PG8_GAS unsigned char* xb = (PG8_GAS unsigned char*)(X + (size_t)rt * 1024);
        f32x4 gq[2][2];
#pragma unroll
        for (int bj = 0; bj < 2; ++bj) { gq[bj][0] = *(const PG8_GAS f32x4*)(gp + bj * HALF); gq[bj][1] = *(const PG8_GAS f32x4*)(gp + bj * HALF + 4); }
        constexpr int MB_ = BASE_F32 ? 2 : 4, NBATCH = 8 / MB_;
#pragma unroll
        for (int ab = 0; ab < NBATCH; ++ab) { const int ai = (ab * MB_) >> 2, m0 = (ab * MB_) & 3; if (ai < nai) {
            f32x4 bf[MB_][2][2]; u32x4 bw[MB_][2];
#pragma unroll
            for (int mm = 0; mm < MB_; ++mm) { const int rl = ai * HALF + wr * 64 + (m0 + mm) * 16 + fr;
#pragma unroll
                for (int bj = 0; bj < 2; ++bj) {
                    if (BASE_F32) { const unsigned of_ = (unsigned)(rl * 1024 + col0 + bj * HALF) * 4u; bf[mm][bj][0] = *(const PG8_GAS f32x4*)(srcb + of_); bf[mm][bj][1] = *(const PG8_GAS f32x4*)(srcb + of_ + 16u); }
                    else bw[mm][bj] = *(const PG8_GAS u32x4*)(xb + (unsigned)(rl * 1024 + col0 + bj * HALF) * 2u); } }
#pragma unroll
            for (int mm = 0; mm < MB_; ++mm) { const int m = m0 + mm; const int rl = ai * HALF + wr * 64 + m * 16 + fr; const float rr = __builtin_amdgcn_rcpf(tw[ai * 64 + m * 16 + fr]);
#pragma unroll
                for (int bj = 0; bj < 2; ++bj) { f32x4 b0, b1;
                    if (BASE_F32) { b0 = bf[mm][bj][0]; b1 = bf[mm][bj][1]; }
                    else { const u32x4 w = bw[mm][bj];
                        b0 = (f32x4){__builtin_bit_cast(float, w.x << 16), __builtin_bit_cast(float, w.x & 0xffff0000u), __builtin_bit_cast(float, w.y << 16), __builtin_bit_cast(float, w.y & 0xffff0000u)};
                        b1 = (f32x4){__builtin_bit_cast(float, w.z << 16), __builtin_bit_cast(float, w.z & 0xffff0000u), __builtin_bit_cast(float, w.w << 16), __builtin_bit_cast(float, w.w & 0xffff0000u)}; }
                    const f32x4 v0 = b0 + gq[bj][0] * (acc[ai][bj][m][0] * rr), v1 = b1 + gq[bj][1] * (acc[ai][bj][m][1] * rr);
                    u32x4 w; w.x = cvt_pk_bf16(v0[0], v0[1]); w.y = cvt_pk_bf16(v0[2], v0[3]); w.z = cvt_pk_bf16(v1[0], v1[1]); w.w = cvt_pk_bf16(v1[2], v1[3]);
                    *(PG8_GAS u32x4*)(xb + (unsigned)(rl * 1024 + col0 + bj * HALF) * 2u) = w; } }
            asm volatile("" ::: "memory"); } }
    }
};
struct EpiWin {
    static constexpr bool PERM = true, AFTER_DRAIN = false, HAS_MID = false;
    EpiBf16<0> base; bf16_t* Qb; bf16_t* Kb; bf16_t* Vb; const float* rope; int rowabs0, rctx; float qscale;
    __device__ __forceinline__ void operator()(const f32x4 (&acc)[2][2][4][2], const Unit& u, int wr, int wc, int fr, int fq) const {
        if (u.pn < 5) { base(acc, u, wr, wc, fr, fq); return; }
        const int half = wc & 1, hsel = wc >> 1; const bool isy = fq >= 2;
#pragma unroll
        for (int ai = 0; ai < 2; ++ai) if (ai < base.nai)
#pragma unroll
            for (int m = 0; m < 4; ++m) { const int ra = rowabs0 + u.pm * base.rpm + wr * 64 + fr + ai * HALF + m * 16; const bool isc = ra < rctx; const int t = (ra - rctx) & 8191;
                const int ti = half ? 128 + (t & 63) : (t >> 6);
                f32x4 cs[4];
                if (!isc) { const float* tb = rope + (ti * 16 + (fq & 1) * 8) * 2;
#pragma unroll
                    for (int q = 0; q < 4; ++q) cs[q] = *(const PG8_GAS f32x4*)(tb + 4 * q); }
#pragma unroll
                for (int bj = 0; bj < 2; ++bj) { float v[8] = {acc[ai][bj][m][0][0], acc[ai][bj][m][0][1], acc[ai][bj][m][0][2], acc[ai][bj][m][0][3], acc[ai][bj][m][1][0], acc[ai][bj][m][1][1], acc[ai][bj][m][1][2], acc[ai][bj][m][1][3]};
                    const bool isv = (u.pn == 7) && (bj == 1);
                    if (!isv && !isc) {
#pragma unroll
                        for (int e2 = 0; e2 < 8; ++e2) { float a_ = v[e2], b_ = v[e2]; asm volatile("s_nop 1\n\tv_permlane32_swap_b32 %0, %1" : "+v"(a_), "+v"(b_));
                            const float other = isy ? a_ : b_;
                            const float c_ = cs[e2 >> 1][2 * (e2 & 1)], s_ = cs[e2 >> 1][2 * (e2 & 1) + 1];
                            v[e2] = v[e2] * c_ + other * (isy ? s_ : -s_); } }
                    bf16_t* dst;
                    if (u.pn < 7) { const int head = (u.pn - 5) * 4 + bj * 2 + hsel; dst = Qb + (size_t)ra * 512 + head * 64 + half * 32 + 8 * fq;
#pragma unroll
                        for (int e2 = 0; e2 < 8; ++e2) v[e2] *= qscale; }
                    else if (bj == 0) dst = Kb + (size_t)ra * 128 + hsel * 64 + half * 32 + 8 * fq;
                    else dst = Vb + (size_t)ra * 128 + wc * 32 + 8 * fq;
                    u32x4 w; w.x = cvt_pk_bf16(v[0], v[1]); w.y = cvt_pk_bf16(v[2], v[3]); w.z = cvt_pk_bf16(v[4], v[5]); w.w = cvt_pk_bf16(v[6], v[7]);
                    *(PG8_GAS u32x4*)dst = w; } }
    }
};
struct EpiWin8 {
    static constexpr bool PERM = true, AFTER_DRAIN = false, HAS_MID = false;
    EpiBf16<0> base; const float* rscale; const float* cscale; bf16_t* Qb; bf16_t* Kb; bf16_t* Vb; const float* rope; int rowabs0, rctx; float qscale;
    __device__ __forceinline__ void operator()(const f32x4 (&acc)[2][2][4][2], const Unit& u, int wr, int wc, int fr, int fq) const {
        const int colb = u.pn * BM + wc * 32 + 8 * fq;
        f32x4 cv[2][2];
#pragma unroll
        for (int bj = 0; bj < 2; ++bj) { cv[bj][0] = *(const PG8_GAS f32x4*)(cscale + colb + bj * HALF); cv[bj][1] = *(const PG8_GAS f32x4*)(cscale + colb + bj * HALF + 4); }
        if (u.pn < 5) {
#pragma unroll
            for (int ai = 0; ai < 2; ++ai) if (ai < base.nai)
#pragma unroll
                for (int m = 0; m < 4; ++m) { const int rl = u.pm * base.rpm + wr * 64 + fr + ai * HALF + m * 16; const float rs = *(const PG8_GAS float*)(rscale + rowabs0 + rl);
                    bf16_t* rowp = base.O + (size_t)rl * base.ldc + colb;
#pragma unroll
                    for (int bj = 0; bj < 2; ++bj) { const i32x4 a0 = __builtin_bit_cast(i32x4, acc[ai][bj][m][0]), a1 = __builtin_bit_cast(i32x4, acc[ai][bj][m][1]);
                        const f32x4 v0 = (f32x4){(float)a0[0], (float)a0[1], (float)a0[2], (float)a0[3]} * rs * cv[bj][0], v1 = (f32x4){(float)a1[0], (float)a1[1], (float)a1[2], (float)a1[3]} * rs * cv[bj][1];
                        u32x4 w; w.x = cvt_pk_bf16(v0[0], v0[1]); w.y = cvt_pk_bf16(v0[2], v0[3]); w.z = cvt_pk_bf16(v1[0], v1[1]); w.w = cvt_pk_bf16(v1[2], v1[3]);
                        *(PG8_GAS u32x4*)(rowp + bj * HALF) = w; } }
            return; }
        const int half = wc & 1, hsel = wc >> 1; const bool isy = fq >= 2;
#pragma unroll
        for (int ai = 0; ai < 2; ++ai) if (ai < base.nai)
#pragma unroll
            for (int m = 0; m < 4; ++m) { const int ra = rowabs0 + u.pm * base.rpm + wr * 64 + fr + ai * HALF + m * 16; const bool isc = ra < rctx; const int t = (ra - rctx) & 8191;
                const int ti = half ? 128 + (t & 63) : (t >> 6);
                f32x4 cs[4];
                if (!isc) { const float* tb = rope + (ti * 16 + (fq & 1) * 8) * 2;
#pragma unroll
                    for (int q = 0; q < 4; ++q) cs[q] = *(const PG8_GAS f32x4*)(tb + 4 * q); }
                const float rs_ = *(const PG8_GAS float*)(rscale + ra);
#pragma unroll
                for (int bj = 0; bj < 2; ++bj) { const i32x4 a0_ = __builtin_bit_cast(i32x4, acc[ai][bj][m][0]), a1_ = __builtin_bit_cast(i32x4, acc[ai][bj][m][1]);
                    float v[8] = {(float)a0_[0] * rs_ * cv[bj][0][0], (float)a0_[1] * rs_ * cv[bj][0][1], (float)a0_[2] * rs_ * cv[bj][0][2], (float)a0_[3] * rs_ * cv[bj][0][3], (float)a1_[0] * rs_ * cv[bj][1][0], (float)a1_[1] * rs_ * cv[bj][1][1], (float)a1_[2] * rs_ * cv[bj][1][2], (float)a1_[3] * rs_ * cv[bj][1][3]};
                    const bool isv = (u.pn == 7) && (bj == 1);
                    if (!isv && !isc) {
#pragma unroll
                        for (int e2 = 0; e2 < 8; ++e2) { float a_ = v[e2], b_ = v[e2]; asm volatile("s_nop 1\n\tv_permlane32_swap_b32 %0, %1" : "+v"(a_), "+v"(b_));
                            const float other = isy ? a_ : b_;
                            const float c_ = cs[e2 >> 1][2 * (e2 & 1)], s_ = cs[e2 >> 1][2 * (e2 & 1) + 1];
                            v[e2] = v[e2] * c_ + other * (isy ? s_ : -s_); } }
                    bf16_t* dst;
                    if (u.pn < 7) { const int head = (u.pn - 5) * 4 + bj * 2 + hsel; dst = Qb + (size_t)ra * 512 + head * 64 + half * 32 + 8 * fq;
#pragma unroll
                        for (int e2 = 0; e2 < 8; ++e2) v[e2] *= qscale; }
                    else if (bj == 0) dst = Kb + (size_t)ra * 128 + hsel * 64 + half * 32 + 8 * fq;
                    else dst = Vb + (size_t)ra * 128 + wc * 32 + 8 * fq;
                    u32x4 w; w.x = cvt_pk_bf16(v[0], v[1]); w.y = cvt_pk_bf16(v[2], v[3]); w.z = cvt_pk_bf16(v[4], v[5]); w.w = cvt_pk_bf16(v[6], v[7]);
                    *(PG8_GAS u32x4*)dst = w; } }
    }
};
struct EpiQ8 {
    static constexpr bool PERM = true, AFTER_DRAIN = false, HAS_MID = false;
    bf16_t* O; const float* rscale; const float* cscale; int rowabs0; int rpm = BM, nai = 2;
    __device__ __forceinline__ void operator()(const f32x4 (&acc)[2][2][4][2], const Unit& u, int wr, int wc, int fr, int fq) const {
        const int c8 = 4 * wc + fq; const int colb = u.pn * BM + wc * 32 + 8 * fq;
        f32x4 cv[2][2];
#pragma unroll
        for (int bj = 0; bj < 2; ++bj) { cv[bj][0] = *(const PG8_GAS f32x4*)(cscale + colb + bj * HALF); cv[bj][1] = *(const PG8_GAS f32x4*)(cscale + colb + bj * HALF + 4); }
#pragma unroll
        for (int ai = 0; ai < 2; ++ai) if (ai < nai)
#pragma unroll
            for (int m = 0; m < 4; ++m) { const int ra = rowabs0 + u.pm * rpm + wr * 64 + fr + ai * HALF + m * 16; const float rs = *(const PG8_GAS float*)(rscale + ra);
                bf16_t* rowp = O + ((size_t)((ra >> 5) * 8 + u.pn) * 2) * 4096 + ((c8 >> 1) * 64 + (c8 & 1) * 32 + (ra & 31)) * 8;
#pragma unroll
                for (int bj = 0; bj < 2; ++bj) { const i32x4 a0 = __builtin_bit_cast(i32x4, acc[ai][bj][m][0]), a1 = __builtin_bit_cast(i32x4, acc[ai][bj][m][1]);
                    const f32x4 v0 = (f32x4){(float)a0[0], (float)a0[1], (float)a0[2], (float)a0[3]} * rs * cv[bj][0], v1 = (f32x4){(float)a1[0], (float)a1[1], (float)a1[2], (float)a1[3]} * rs * cv[bj][1];
                    u32x4 w; w.x = cvt_pk_bf16(v0[0], v0[1]); w.y = cvt_pk_bf16(v0[2], v0[3]); w.z = cvt_pk_bf16(v1[0], v1[1]); w.w = cvt_pk_bf16(v1[2], v1[3]);
                    *(PG8_GAS u32x4*)(rowp + bj * 4096) = w; } }
    }
};
struct OrderHalf {
    int nph, nN, pn0, G, c;
    __host__ __device__ void init(int nph_, int nN_, int pn0_, int G_, int c_) { nph = nph_; nN = nN_; pn0 = pn0_; G = G_; c = c_; }
    __host__ __device__ bool next(int i, Unit& u) const { const long L = (long)i * G + c; if (L >= (long)nph * nN) return false; u.pm = (int)(L % nph); u.pn = pn0 + (int)(L / nph); return true; }
    __device__ __forceinline__ void a_ready(const Unit&) const {}
    __device__ __forceinline__ void done(const Unit&) const {}
};
struct OrderLast {
    StaticOrder S; int G, c;
    __host__ __device__ void init(int G_, int c_) { S.init(32768, 2048, G_, c_); G = G_; c = c_; }
    __host__ __device__ bool next(int i, Unit& u) const {
        const long L = (long)i * G + c;
        if (L < 1024) { const bool ok = S.next(i, u); u.pm += 4; return ok; }
        if (L < 1028) { u.pm = (int)(L - 1024); u.pn = 7; return true; }
        return false;
    }
    __device__ __forceinline__ void a_ready(const Unit&) const {}
    __device__ __forceinline__ void done(const Unit&) const {}
};
template <class Epi, class Sched, bool ALIGN_EPI = false, bool SP2 = false, bool HALFM = false, bool I8 = false>
__device__ __forceinline__ void gemm_phase(PG8_LAS unsigned char* lds, const Gemm g, const Sched& S, const Epi& E, int tid_in) {
    int tid_l = tid_in; asm volatile("" : "+v"(tid_l));
    const int tid = tid_l, wid = __builtin_amdgcn_readfirstlane(tid >> 6), lane = tid & 63, wr = wid >> 2, wc = wid & 3, fr = lane & 15, fq = lane >> 4;
    const int K = g.K, nt = I8 ? K / (2 * BK) : K / BK; constexpr unsigned ES = I8 ? 1u : 2u;
    unsigned voffA[2], voffB[2];
#pragma unroll
    for (int i = 0; i < 2; ++i) { int R, C; stage_rc(tid * 16 + i * 8192, R, C); const int Rb = Epi::PERM ? ((R & ~31) + perm32(R & 31)) : R;
        voffA[i] = (unsigned)(R * K) * ES + (unsigned)C * 2u; voffB[i] = (unsigned)(Rb * K) * ES + (unsigned)C * 2u; }
    const size_t kstep = (size_t)(BK * 2);
    const size_t hstep = (size_t)HALF * K * ES;
    const size_t tstep = 2 * hstep;
    const unsigned ldsw = (unsigned)wid * 1024u;
    const int aoff = lds_byte(wr * 64 + fr, fq * 8), boff = lds_byte(wc * 32 + fr, fq * 8);
#define PG8_SA(b, h) (((b) * 2 + (h)) * HTB)
#define PG8_SB(b, h) ((4 + (b) * 2 + (h)) * HTB)
#define PG8_STAGE(bufoff, gbase, voff) do { _Pragma("unroll") for (int _i = 0; _i < 2; ++_i) \
        __builtin_amdgcn_global_load_lds((const unsigned*)((const char*)(gbase) + (voff)[_i]), (PG8_LAS unsigned*)(lds + (bufoff) + ldsw + _i * 8192), 16, 0, 0); } while (0)
#define PG8_LDA(dst, b, h) do { _Pragma("unroll") for (int m = 0; m < 4; ++m) _Pragma("unroll") for (int k = 0; k < 2; ++k) dst[m][k] = *(const PG8_LAS bf16x8*)(lds + PG8_SA(b, h) + aoff + m * 2048 + k * 1024); } while (0)
#define PG8_LDB(dst, b, h) do { _Pragma("unroll") for (int n = 0; n < 2; ++n) _Pragma("unroll") for (int k = 0; k < 2; ++k) dst[n][k] = *(const PG8_LAS bf16x8*)(lds + PG8_SB(b, h) + boff + n * 2048 + k * 1024); } while (0)
#define PG8_MMA(ai, bj, At, Bt) do { __builtin_amdgcn_s_setprio(1); _Pragma("unroll") for (int m = 0; m < 4; ++m) _Pragma("unroll") for (int n = 0; n < 2; ++n) _Pragma("unroll") for (int k = 0; k < 2; ++k) \
        { if constexpr (I8) acc[ai][bj][m][n] = __builtin_bit_cast(f32x4, __builtin_amdgcn_mfma_i32_16x16x64_i8(__builtin_bit_cast(i32x4, Bt[n][k]), __builtin_bit_cast(i32x4, At[m][k]), __builtin_bit_cast(i32x4, acc[ai][bj][m][n]), 0, 0, 0)); \
          else acc[ai][bj][m][n] = __builtin_amdgcn_mfma_f32_16x16x32_bf16(Bt[n][k], At[m][k], acc[ai][bj][m][n], 0, 0, 0); } __builtin_amdgcn_s_setprio(0); } while (0)
#define PG8_WAIT_V(n) asm volatile("s_waitcnt vmcnt(" #n ")" ::: "memory")
#define PG8_WAIT_L(n) asm volatile("s_waitcnt lgkmcnt(" #n ")" ::: "memory")
#define PG8_BAR __builtin_amdgcn_s_barrier()
#define PG8_SCHED __builtin_amdgcn_sched_barrier(0)
    Unit cur, nxt; int ui = 0;
    if (!S.next(0, cur)) return;
    f32x4 acc[2][2][4][2];
#pragma unroll
    for (int a = 0; a < 2; ++a)
#pragma unroll
        for (int b = 0; b < 2; ++b)
#pragma unroll
            for (int m = 0; m < 4; ++m)
#pragma unroll
                for (int n = 0; n < 2; ++n) acc[a][b][m][n] = (f32x4){0.f, 0.f, 0.f, 0.f};
    bf16x8 At[4][2], B0[2][2], B1[2][2];
    const size_t astep = HALFM ? hstep : tstep;
    const char* cA = (const char*)g.A + (size_t)cur.pm * astep; const char* cB = (const char*)g.Bt + (size_t)cur.pn * tstep;
    S.a_ready(cur);
    if constexpr (Epi::HAS_MID) E.pre(cur, wr, wc, fr, fq);
    if constexpr (SP2) {
        PG8_STAGE(PG8_SB(0, 0), cB, voffB); PG8_STAGE(PG8_SB(0, 1), cB + hstep, voffB); PG8_STAGE(PG8_SA(0, 0), cA, voffA); PG8_STAGE(PG8_SA(0, 1), cA + hstep, voffA);
        if (wr == 1) PG8_BAR;
        PG8_WAIT_V(2); PG8_BAR;
        PG8_STAGE(PG8_SB(1, 0), cB + kstep, voffB); PG8_STAGE(PG8_SA(1, 0), cA + kstep, voffA); PG8_STAGE(PG8_SB(1, 1), cB + hstep + kstep, voffB);
        PG8_WAIT_V(6); PG8_BAR;
    } else {
        PG8_STAGE(PG8_SB(0, 0), cB, voffB); PG8_STAGE(PG8_SA(0, 0), cA, voffA); PG8_STAGE(PG8_SB(0, 1), cB + hstep, voffB); PG8_STAGE(PG8_SA(0, 1), cA + hstep, voffA);
        if (wr == 1) PG8_BAR;
        PG8_WAIT_V(4); PG8_BAR;
        PG8_STAGE(PG8_SB(1, 0), cB + kstep, voffB); PG8_STAGE(PG8_SA(1, 0), cA + kstep, voffA); PG8_STAGE(PG8_SB(1, 1), cB + hstep + kstep, voffB);
        PG8_WAIT_V(6); PG8_BAR;
    }
    for (;;) {
        const bool has_next = S.next(ui + 1, nxt);
        const char* nA = has_next ? (const char*)g.A + (size_t)nxt.pm * astep : cA; const char* nB = has_next ? (const char*)g.Bt + (size_t)nxt.pn * tstep : cB;
        for (int t = 0; t < nt; t += 2) {
            if constexpr (Epi::HAS_MID) { if (t == nt / 2) E.mid(acc, cur, wr, wc, fr, fq); }
            const bool last = (t == nt - 2);
            const char* a1 = cA + (size_t)(t + 1) * kstep;
            const char* a2 = last ? nA : cA + (size_t)(t + 2) * kstep; const char* b2 = last ? nB : cB + (size_t)(t + 2) * kstep;
            const char* a3 = a2 + kstep; const char* b3 = b2 + kstep;
            if (last && has_next) S.a_ready(nxt);
            if constexpr (SP2) {
            PG8_LDB(B0, 0, 0); PG8_LDB(B1, 0, 1); PG8_SCHED; PG8_LDA(At, 0, 0); PG8_STAGE(PG8_SA(1, 1), a1 + hstep, voffA);
            PG8_WAIT_V(8); PG8_WAIT_L(0); PG8_BAR; PG8_MMA(0, 0, At, B0); PG8_MMA(0, 1, At, B1); PG8_BAR; PG8_SCHED;
            PG8_LDA(At, 0, 1); PG8_STAGE(PG8_SB(0, 0), b2, voffB); PG8_STAGE(PG8_SB(0, 1), b2 + hstep, voffB); PG8_STAGE(PG8_SA(0, 0), a2, voffA);
            PG8_WAIT_V(8); PG8_WAIT_L(0); PG8_BAR; if constexpr (!HALFM) { PG8_MMA(1, 0, At, B0); PG8_MMA(1, 1, At, B1); } PG8_BAR; PG8_SCHED;
            PG8_LDB(B0, 1, 0); PG8_LDB(B1, 1, 1); PG8_SCHED; PG8_LDA(At, 1, 0); PG8_STAGE(PG8_SA(0, 1), a2 + hstep, voffA);
            PG8_WAIT_V(8); PG8_WAIT_L(0); PG8_BAR; PG8_MMA(0, 0, At, B0); PG8_MMA(0, 1, At, B1); PG8_BAR; PG8_SCHED;
            PG8_LDA(At, 1, 1); PG8_STAGE(PG8_SB(1, 0), b3, voffB); PG8_STAGE(PG8_SB(1, 1), b3 + hstep, voffB); PG8_STAGE(PG8_SA(1, 0), a3, voffA);
            PG8_WAIT_V(8); PG8_WAIT_L(0); PG8_BAR; if constexpr (!HALFM) { PG8_MMA(1, 0, At, B0); PG8_MMA(1, 1, At, B1); } PG8_BAR; PG8_SCHED;
            } else {
            PG8_LDB(B0, 0, 0); PG8_SCHED; PG8_LDA(At, 0, 0); PG8_STAGE(PG8_SA(1, 1), a1 + hstep, voffA);
            PG8_WAIT_L(8); PG8_BAR; PG8_WAIT_L(0); PG8_MMA(0, 0, At, B0); PG8_BAR; PG8_SCHED;
            PG8_LDB(B1, 0, 1); PG8_STAGE(PG8_SB(0, 0), b2, voffB);
            PG8_BAR; PG8_WAIT_L(0); PG8_MMA(0, 1, At, B1); PG8_BAR;
            PG8_LDA(At, 0, 1); PG8_STAGE(PG8_SA(0, 0), a2, voffA);
            PG8_BAR; PG8_WAIT_L(0); PG8_MMA(1, 0, At, B0); PG8_BAR; PG8_SCHED;
            PG8_STAGE(PG8_SB(0, 1), b2 + hstep, voffB);
            PG8_WAIT_V(6); PG8_BAR; PG8_MMA(1, 1, At, B1); PG8_BAR;
            PG8_LDB(B0, 1, 0); PG8_SCHED; PG8_LDA(At, 1, 0); PG8_STAGE(PG8_SA(0, 1), a2 + hstep, voffA);
            PG8_WAIT_L(8); PG8_BAR; PG8_WAIT_L(0); PG8_MMA(0, 0, At, B0); PG8_BAR; PG8_SCHED;
            PG8_LDB(B1, 1, 1); PG8_STAGE(PG8_SB(1, 0), b3, voffB);
            PG8_BAR; PG8_WAIT_L(0); PG8_MMA(0, 1, At, B1); PG8_BAR;
            PG8_LDA(At, 1, 1); PG8_STAGE(PG8_SA(1, 0), a3, voffA);
            PG8_BAR; PG8_WAIT_L(0); PG8_MMA(1, 0, At, B0); PG8_BAR; PG8_SCHED;
            PG8_STAGE(PG8_SB(1, 1), b3 + hstep, voffB);
            PG8_WAIT_V(6); PG8_BAR; PG8_MMA(1, 1, At, B1); PG8_BAR;
            }
        }
        if constexpr (ALIGN_EPI) { if (wr == 0) PG8_BAR; }
        if constexpr (!Epi::AFTER_DRAIN) { E(acc, cur, wr, wc, fr, fq); S.done(cur); }
        if (!has_next) break;
#pragma unroll
        for (int a = 0; a < 2; ++a)
#pragma unroll
            for (int b = 0; b < 2; ++b)
#pragma unroll
                for (int m = 0; m < 4; ++m)
#pragma unroll
                    for (int n = 0; n < 2; ++n) acc[a][b][m][n] = (f32x4){0.f, 0.f, 0.f, 0.f};
        cur = nxt; cA = nA; cB = nB; ++ui;
        if constexpr (Epi::HAS_MID) E.pre(cur, wr, wc, fr, fq);
        if constexpr (ALIGN_EPI) { if (wr == 1) PG8_BAR; }
    }
    PG8_WAIT_V(0);
    if constexpr (!ALIGN_EPI) { if (wr == 0) PG8_BAR; }
    PG8_BAR;
    if constexpr (Epi::AFTER_DRAIN) { E.fused(acc, cur, wr, wc, fr, fq, lds, wid, lane); S.done(cur); }
#undef PG8_SA
#undef PG8_SB
#undef PG8_STAGE
#undef PG8_LDA
#undef PG8_LDB
#undef PG8_MMA
#undef PG8_WAIT_V
#undef PG8_WAIT_L
#undef PG8_BAR
#undef PG8_SCHED
}
}
#define GAS __attribute__((address_space(1)))
#define LAS __attribute__((address_space(3)))
typedef unsigned short bf16;
typedef unsigned v4u __attribute__((ext_vector_type(4)));
typedef float f32x4 __attribute__((ext_vector_type(4)));
typedef short bf16x8 __attribute__((ext_vector_type(8)));
typedef GAS unsigned gu32;
typedef GAS unsigned long long gu64;
#define RLX_AGENT __ATOMIC_RELAXED, __HIP_MEMORY_SCOPE_AGENT
#define LDS_WAIT() asm volatile("s_waitcnt lgkmcnt(0)" ::: "memory")
#define VM_WAIT() asm volatile("s_waitcnt vmcnt(0)" ::: "memory")
__device__ __forceinline__ unsigned long long rt() { return __builtin_amdgcn_s_memrealtime(); }
typedef float pk_f32x2 __attribute__((ext_vector_type(2))); typedef __bf16 pk_bf16x2 __attribute__((ext_vector_type(2)));
__device__ __forceinline__ unsigned pk2(float lo, float hi) { const pk_f32x2 v = {lo, hi}; return __builtin_bit_cast(unsigned, __builtin_convertvector(v, pk_bf16x2)); }
__device__ __forceinline__ unsigned f2bf(float f) { return pk2(f, 0.f) & 0xffffu; }

#define XB_TMO      128
#define XB_XCNT(j)  (256  + 64 * (j))
#define XB_XSUB(j)  (1280 + 64 * (j))
#define XB_XGEN(j)  (2304 + 64 * (j))
#define XB_TOP      3328
#define XB_TOPGEN   3392
#define XCD_BAR_WORDS 3456
#define XB_SPIN_CAP (1u << 18)

__device__ __forceinline__ unsigned xb_ld(unsigned* p)              { return __hip_atomic_load(p, __ATOMIC_RELAXED, __HIP_MEMORY_SCOPE_AGENT); }
__device__ __forceinline__ unsigned xb_add(unsigned* p, unsigned v) { return __hip_atomic_fetch_add(p, v, __ATOMIC_RELAXED, __HIP_MEMORY_SCOPE_AGENT); }
__device__ __forceinline__ unsigned xb_xcc_id() { return (unsigned)__builtin_amdgcn_s_getreg((3 << 11) | 20) & 0xFu; }
#define XB_SPIN(cond, bar) do { unsigned _sp = 0; while (cond) { __builtin_amdgcn_s_sleep(1); \
    if ((++_sp & 255u) == 0u) { if (xb_ld(&(bar)[XB_TMO])) break; if (_sp > XB_SPIN_CAP) { atomicAdd(&(bar)[XB_TMO], 1u); break; } } } } while (0)

struct XcdBarrier {
    unsigned* bar; unsigned x;
    volatile LAS unsigned* st;
};

__device__ __forceinline__ XcdBarrier xcd_barrier_post(unsigned* bar, volatile LAS unsigned* st) {
    XcdBarrier b; b.bar = bar; b.x = xb_xcc_id(); b.st = st;
    if (threadIdx.x == 0) (void)xb_add(&bar[XB_XCNT(b.x)], 1u);
    return b;
}
__device__ __forceinline__ void xcd_barrier_complete(unsigned* bar, unsigned x, unsigned& nloc, unsigned& nx, unsigned& mask) {
    const unsigned G = gridDim.x * gridDim.y * gridDim.z;
    unsigned sum, cnt, mine, sp = 0u;
    for (;;) {
        sum = 0u; cnt = 0u; mine = 0u; mask = 0u;
#pragma unroll
        for (unsigned j = 0; j < 16; ++j) { const unsigned c = xb_ld(&bar[XB_XCNT(j)]); sum += c; cnt += (c > 0u) ? 1u : 0u; mask |= (c > 0u) ? (1u << j) : 0u; mine = (j == x) ? c : mine; }
        if (sum == G) break;
        __builtin_amdgcn_s_sleep(1);
        if ((++sp & 255u) == 0u) { if (xb_ld(&bar[XB_TMO])) break; if (sp > XB_SPIN_CAP) { atomicAdd(&bar[XB_TMO], 1u); break; } }
    }
    nloc = mine > 0u ? mine : 1u; nx = cnt > 0u ? cnt : 1u; mask |= 1u << x;
}

__device__ __forceinline__ void xcd_barrier(const XcdBarrier& b, int tid_in) {
    asm volatile("s_waitcnt vmcnt(0)" ::: "memory");
    __syncthreads();
    if (tid_in == 0) {
        unsigned* bar = b.bar;
        __builtin_amdgcn_s_waitcnt(0);
        unsigned nloc = b.st[0], nx = b.st[1];
        if (nloc == 0u) { unsigned mask; xcd_barrier_complete(bar, b.x, nloc, nx, mask); b.st[0] = nloc; b.st[1] = nx; b.st[2] = mask; }
        const unsigned old = xb_add(&bar[XB_XSUB(b.x)], 1u);
        const unsigned gen = old / nloc;
        if (old + 1u == (gen + 1u) * nloc) {
            asm volatile("buffer_inv sc1 ; leader: runs beside the write-back below" ::: "memory");
            __builtin_amdgcn_fence(__ATOMIC_RELEASE, "agent");
            asm volatile("s_waitcnt vmcnt(0)" ::: "memory");
            { const unsigned mask = b.st[2];
#pragma unroll
              for (unsigned j = 0; j < 16; ++j) if ((mask >> j) & 1u) (void)xb_add(&bar[XB_XGEN(j)], 1u); }
            XB_SPIN(xb_ld(&bar[XB_XGEN(b.x)]) < (gen + 1u) * nx, bar);
            asm volatile("s_waitcnt vmcnt(0)" ::: "memory");
        } else {
            asm volatile("buffer_inv sc1 ; waiter: runs beside the wait below" ::: "memory");
            XB_SPIN(xb_ld(&bar[XB_XGEN(b.x)]) < (gen + 1u) * nx, bar);
            asm volatile("s_waitcnt vmcnt(0)" ::: "memory");
        }
    }
    __syncthreads();
}
constexpr int D = 1024, NB = 4, SEQ = 8192, CTXL = 256, DEPTH = 2;
constexpr int R_CTX = NB * CTXL, R_LAT = NB * SEQ, R = R_CTX + R_LAT;
constexpr int D_IN = 2048, NMOD = 6 * D, NEXP = 16384;
constexpr int C_CONVB = 0, C_CONVC = 256, C_CONVX = 512, C_SGUU = 768, C_SGUV = 1024, C_Q = 1280, C_K = 1792, C_V = 1920;
constexpr float EPS = 1e-6f;
constexpr float LOG2E = 1.4426950408889634f;
constexpr float QSCALE = 0.125f * LOG2E;
constexpr int NWAVES = 8;
constexpr size_t MiB = 1u << 20;
constexpr size_t WS_CTL = 0, CTL_ZERO_BYTES = 64 * 1024;
constexpr size_t WS_MODS = 1 * MiB, WS_ROPE = 1 * MiB + 256 * 1024, WS_SCALE = 1 * MiB + 512 * 1024;
constexpr size_t WS_WIN = 2 * MiB, WS_WOUT = 10 * MiB, WS_WQ = 14 * MiB, WS_TABU = 22 * MiB, WS_TABV = 54 * MiB, WS_X = 86 * MiB, WS_XN = 152 * MiB;
constexpr size_t WS_P = 218 * MiB, WS_Y = 350 * MiB, WS_Q = 416 * MiB, WS_K = 449 * MiB, WS_V = 458 * MiB, WS_SSQ = 467 * MiB, WS_EIDX = 469 * MiB, WS_GATE = 478 * MiB, WS_KEYS = 495 * MiB, WS_HSC = 496 * MiB, WS_CSUM = 496 * MiB + 512 * 1024, WS_COEF = 497 * MiB, WS_SGUW = 502 * MiB, WS_END = 503 * MiB;
constexpr size_t WS_WIN8 = 46 * MiB, WS_WINS = 51 * MiB;
constexpr size_t WS_WQ8 = 40 * MiB, WS_WQS = 45 * MiB;
constexpr size_t WS_H8 = WS_Y;
constexpr size_t WS_PART = WS_P;
constexpr int CW_RANK = 8192;
constexpr int CW_BAR = 1024;
constexpr int LDS_BYTES = 147456, MISC_OFF = 147456 - 512;

__device__ __forceinline__ int row_modb(int r) { return r < R_CTX ? 4 : ((r - R_CTX) >> 13); }
__device__ __forceinline__ int row_t(int r) { return r < R_CTX ? (r & 255) : ((r - R_CTX) & 8191); }
__device__ __forceinline__ float bf2f(unsigned short h) { return __builtin_bit_cast(float, (unsigned)h << 16); }
__device__ __forceinline__ float bflo(unsigned w) { return __builtin_bit_cast(float, w << 16); }
__device__ __forceinline__ float bfhi(unsigned w) { return __builtin_bit_cast(float, w & 0xffff0000u); }
__device__ __forceinline__ int lane_now() { int l; asm volatile("v_mbcnt_lo_u32_b32 %0, -1, 0\n\tv_mbcnt_hi_u32_b32 %0, -1, %0" : "=v"(l)); return l; }
__device__ __forceinline__ float shflx(float v, int m) { return __builtin_bit_cast(float, __builtin_amdgcn_ds_bpermute((lane_now() ^ m) << 2, __builtin_bit_cast(int, v))); }
__device__ __forceinline__ int shflx(int v, int m) { return __builtin_amdgcn_ds_bpermute((lane_now() ^ m) << 2, v); }
template <int CTRL> __device__ __forceinline__ int dpp_i(int v) { return __builtin_amdgcn_update_dpp(0, v, CTRL, 0xf, 0xf, true); }
template <int CTRL> __device__ __forceinline__ float dpp_f(float v) { return __builtin_bit_cast(float, __builtin_amdgcn_update_dpp(0, __builtin_bit_cast(int, v), CTRL, 0xf, 0xf, true)); }
struct OpSum { __device__ __forceinline__ float operator()(float a, float b) const { return a + b; } };
struct OpMax { __device__ __forceinline__ float operator()(float a, float b) const { return fmaxf(a, b); } };
template <class Op> __device__ __forceinline__ float red_row16(float v, Op op) { v = op(v, dpp_f<0xB1>(v)); v = op(v, dpp_f<0x4E>(v)); v = op(v, dpp_f<0x141>(v)); v = op(v, dpp_f<0x140>(v)); return v; }
template <class Op> __device__ __forceinline__ float red_x16(float v, Op op) { float a_ = v, b_ = v; asm volatile("s_nop 1\n\tv_permlane16_swap_b32 %0, %1" : "+v"(a_), "+v"(b_)); return op(a_, b_); }
template <class Op> __device__ __forceinline__ float red_x32(float v, Op op) { float a_ = v, b_ = v; asm volatile("s_nop 1\n\tv_permlane32_swap_b32 %0, %1" : "+v"(a_), "+v"(b_)); return op(a_, b_); }
__device__ __forceinline__ float wave_sum(float v) { return red_x32(red_x16(red_row16(v, OpSum()), OpSum()), OpSum()); }
__device__ __forceinline__ float wave_max(float v) { return red_x32(red_x16(red_row16(v, OpMax()), OpMax()), OpMax()); }
__device__ __forceinline__ float half_sum32(float v) { return red_x16(red_row16(v, OpSum()), OpSum()); }
__device__ __forceinline__ float gelu_tanh(float x) {
    const float y = 1.5957691216057308f * (x + 0.044715f * x * x * x);
    return x * __builtin_amdgcn_rcpf(1.0f + __expf(-y));
}
__device__ __forceinline__ float silu(float x) { return x * __builtin_amdgcn_rcpf(1.0f + __expf(-x)); }
__device__ __forceinline__ void unpack8(const v4u w, float (&f)[8]) { f[0] = bflo(w.x); f[1] = bfhi(w.x); f[2] = bflo(w.y); f[3] = bfhi(w.y); f[4] = bflo(w.z); f[5] = bfhi(w.z); f[6] = bflo(w.w); f[7] = bfhi(w.w); }
__device__ __forceinline__ v4u pack8(const float (&f)[8]) { v4u w; w.x = pk2(f[0], f[1]); w.y = pk2(f[2], f[3]); w.z = pk2(f[4], f[5]); w.w = pk2(f[6], f[7]); return w; }

struct Args { const float* in[21]; float* out; unsigned char* ws; int ph_lo, ph_hi; };
enum { I_X = 0, I_C, I_CTX, I_CCTX, I_WADA, I_BADA, I_N1G, I_N2G, I_WIN, I_CONVW, I_SGUG, I_SGUW, I_SGUB, I_SINK, I_MIXG, I_WOUT, I_WQ, I_KEYS, I_PU, I_PV, I_FING };

struct TItem { const float* W; bf16* WT; const float* ks; int N, k0, n0; };
__device__ __forceinline__ void titem_load(const TItem& t, int lane, float (&tv)[32]) {
#pragma unroll
    for (int i = 0; i < 32; ++i) tv[i] = t.W[(size_t)(t.k0 + 2 * i + (lane >> 5)) * t.N + t.n0 + (lane & 31)];
}
__device__ __forceinline__ void titem_finish(const TItem& t, int lane, const float (&tv)[32], LAS float* scr) {
#pragma unroll
    for (int i = 0; i < 32; ++i) { const int kk = 2 * i + (lane >> 5); float v = tv[i]; if (t.ks) v *= t.ks[t.k0 + kk]; scr[kk * 33 + (lane & 31)] = v; }
    LDS_WAIT(); asm volatile("" ::: "memory");
    const int c = lane & 7;
#pragma unroll
    for (int j = 0; j < 4; ++j) { const int n = (lane >> 3) + 8 * j; const LAS float* s = scr + (8 * c) * 33 + n;
        v4u o; o.x = pk2(s[0 * 33], s[1 * 33]); o.y = pk2(s[2 * 33], s[3 * 33]); o.z = pk2(s[4 * 33], s[5 * 33]); o.w = pk2(s[6 * 33], s[7 * 33]);
        *(GAS v4u*)(t.WT + (size_t)(t.n0 + n) * D + t.k0 + 8 * c) = o; }
    LDS_WAIT(); asm volatile("" ::: "memory");
}

__device__ __forceinline__ const float* table_src(const Args& a, int row, int lane) { const int t = row >> 14, e = row & (NEXP - 1); return ((t >> 1) ? a.in[I_PV] : a.in[I_PU]) + ((size_t)(t & 1) * NEXP + e) * D + 16 * lane; }
__device__ __forceinline__ void quant_store(unsigned char* ws, int row, int lane, const f32x4 (&v)[4]) {
    const int t = row >> 14, e = row & (NEXP - 1), layer = t & 1, isv = t >> 1;
    float ss = 0.f;
#pragma unroll
    for (int j = 0; j < 4; ++j) ss += (v[j].x * v[j].x + v[j].y * v[j].y) + (v[j].z * v[j].z + v[j].w * v[j].w);
    const float step = fmaxf(0.34f * __builtin_amdgcn_sqrtf(wave_sum(ss) * (1.0f / D)), 1e-30f), inv = __builtin_amdgcn_rcpf(step);
    unsigned w[2];
#pragma unroll
    for (int hd = 0; hd < 2; ++hd) { unsigned xu = 0, xv = 0;
#pragma unroll
        for (int n = 0; n < 8; ++n) { int q = (int)rintf(v[2 * hd + (n >> 2)][n & 3] * inv); q = q < -7 ? -7 : (q > 7 ? 7 : q);
            xu |= (unsigned)(q & 15) << (4 * n); xv |= (unsigned)((n < 4 ? q + 8 : q) & 15) << (8 * (n & 3) + 4 * (n >> 2)); }
        w[hd] = isv ? xv : xu; }
    unsigned char* dst = ws + (isv ? WS_TABV : WS_TABU) + (size_t)layer * NEXP * 512 + (size_t)(lane >> 4) * (NEXP * 128) + (size_t)e * 128;
    *(GAS unsigned long long*)(dst + (lane & 15) * 8) = (unsigned long long)w[0] | ((unsigned long long)w[1] << 32);
    if (lane == 0) ((GAS float*)(ws + WS_SCALE))[(size_t)t * NEXP + e] = step;
}
__device__ __forceinline__ void quant_rows(const Args& a, unsigned char* ws, int r0, int r1, int stride, int lane, bool l0 = false) {
    constexpr int QR = 8;
    for (int row = r0; row < r1; row += QR * stride) {
        f32x4 v[QR][4];
#pragma unroll
        for (int q = 0; q < QR; ++q) { int rq = row + q * stride < r1 ? row + q * stride : row; if (l0 && rq >= NEXP) rq += NEXP; const float* src = table_src(a, rq, lane);
#pragma unroll
            for (int j = 0; j < 4; ++j) v[q][j] = *(const GAS f32x4*)(src + 4 * j); }
#pragma unroll
        for (int q = 0; q < QR; ++q) if (row + q * stride < r1) { int rq = row + q * stride; if (l0 && rq >= NEXP) rq += NEXP; quant_store(ws, rq, lane, v[q]); }
    }
}
__device__ __forceinline__ void tail_quant(const Args& a, unsigned char* ws, int k, int c, int G, int wave, int lane) {
    const int busy[3] = {64, 32, 64};
    int tot = 0, before = 0;
#pragma unroll
    for (int i = 0; i < 3; ++i) { const int idle = G > busy[i] ? G - busy[i] : 0; if (i < k) before += idle; tot += idle; }
    if (tot == 0) { if (k == 2) quant_rows(a, ws, c * NWAVES + wave, 2 * NEXP, G * NWAVES, lane, true); return; }
    if (c < busy[k]) return;
    const int per = (2 * NEXP + tot - 1) / tot, q = before + (c - busy[k]);
    const int r0 = q * per, r1 = (r0 + per < 2 * NEXP) ? r0 + per : 2 * NEXP;
    quant_rows(a, ws, r0 + wave, r1, NWAVES, lane, true);
}
__device__ __forceinline__ void ph_prologue(const Args& a, LAS unsigned char* L, int tid, int lane, int wave, int vcu, int G) {
    unsigned char* ws = a.ws;
    const int gw = vcu * NWAVES + wave, NGW = G * NWAVES;
    if (vcu < 192) {
        LAS float* sc = (LAS float*)L;
        LAS float* part = (LAS float*)(L + 20480);
        for (int i = tid; i < 5 * D; i += 512) { const int b = i >> 10, k = i & 1023; sc[i] = silu(b < 4 ? a.in[I_C][b * D + k] : a.in[I_CCTX][k]); }
        __syncthreads();
        for (int it = vcu; it < 192; it += G) {
            const int layer = it / 96, n = (it % 96) * 64 + lane;
            const float* W = a.in[I_WADA] + (size_t)layer * D * NMOD + n;
            float a0 = 0.f, a1 = 0.f, a2 = 0.f, a3 = 0.f, a4 = 0.f;
#pragma unroll 64
            for (int kk = 0; kk < 128; ++kk) { const int k = wave * 128 + kk; const float w = W[(size_t)k * NMOD];
                a0 += sc[k] * w; a1 += sc[1024 + k] * w; a2 += sc[2048 + k] * w; a3 += sc[3072 + k] * w; a4 += sc[4096 + k] * w; }
            part[(wave * 5 + 0) * 64 + lane] = a0; part[(wave * 5 + 1) * 64 + lane] = a1; part[(wave * 5 + 2) * 64 + lane] = a2; part[(wave * 5 + 3) * 64 + lane] = a3; part[(wave * 5 + 4) * 64 + lane] = a4;
            __syncthreads();
            if (tid < 320) { const int b = tid >> 6, l2 = tid & 63; float s = 0.f;
#pragma unroll
                for (int w = 0; w < 8; ++w) s += part[(w * 5 + b) * 64 + l2];
                const int nn = (it % 96) * 64 + l2;
                ((GAS float*)(ws + WS_MODS))[((size_t)layer * 5 + b) * NMOD + nn] = s + a.in[I_BADA][layer * NMOD + nn]; }
            __syncthreads();
        }
    }
    {
        LAS float* scr = (LAS float*)(L + 32768 + wave * 8704);
        constexpr int I_IN = 16 * 64, I_OUT = 16 * 32, I_Q_ = 16 * 64, PER_L = I_IN + I_OUT + I_Q_, NPAIR = DEPTH * PER_L / 2;
        int p0, pend, pstep;
        if (G == 256) { if (vcu < 192) { p0 = gw; pend = p0 + 1; } else { p0 = 1536 + 2 * ((vcu - 192) * NWAVES + wave); pend = p0 + 2; } pstep = 1; }
        else { p0 = gw; pend = NPAIR; pstep = NGW; }
        for (int pp = p0; pp < pend && pp < NPAIR; pp += pstep) {
            TItem t[2];
#pragma unroll
            for (int q = 0; q < 2; ++q) { const int it = 2 * pp + q; const int layer = it / PER_L; int r = it % PER_L;
                if (r < I_IN) { t[q].W = a.in[I_WIN] + (size_t)layer * D * D_IN; t[q].N = D_IN; t[q].WT = (bf16*)(ws + WS_WIN) + (size_t)layer * D_IN * D; t[q].ks = nullptr; }
                else if (r < I_IN + I_OUT) { r -= I_IN; t[q].W = a.in[I_WOUT] + (size_t)layer * D * D; t[q].N = D; t[q].WT = (bf16*)(ws + WS_WOUT) + (size_t)layer * D * D; t[q].ks = a.in[I_MIXG] + layer * D; }
                else { r -= I_IN + I_OUT; t[q].W = a.in[I_WQ] + (size_t)layer * D * 2048; t[q].N = 2048; t[q].WT = (bf16*)(ws + WS_WQ) + (size_t)layer * 2048 * D; t[q].ks = nullptr; }
                const int nblk = t[q].N / 32; t[q].k0 = 64 * (r / nblk); t[q].n0 = 32 * (r % nblk); }
            float ta[32], tb[32];
            titem_load(t[0], lane, ta); titem_load(t[1], lane, tb);
            titem_finish(t[0], lane, ta, scr); titem_finish(t[1], lane, tb, scr);
        }
    }
    for (int g8 = vcu * 512 + tid; g8 < DEPTH * 4 * 128 * 128 / 8; g8 += G * 512) {
        const f32x4 k0 = *(const GAS f32x4*)(a.in[I_SGUW] + (size_t)g8 * 8), k1 = *(const GAS f32x4*)(a.in[I_SGUW] + (size_t)g8 * 8 + 4);
        v4u o; o.x = pk2(k0.x, k0.y); o.y = pk2(k0.z, k0.w); o.z = pk2(k1.x, k1.y); o.w = pk2(k1.z, k1.w);
        *(GAS v4u*)((bf16*)(ws + WS_SGUW) + (size_t)g8 * 8) = o;
    }
    for (int g8 = vcu * 512 + tid; g8 < DEPTH * 8 * 2 * 128 * 128 / 8; g8 += G * 512) {
        const f32x4 k0 = *(const GAS f32x4*)(a.in[I_KEYS] + (size_t)g8 * 8), k1 = *(const GAS f32x4*)(a.in[I_KEYS] + (size_t)g8 * 8 + 4);
        v4u o; o.x = pk2(k0.x, k0.y); o.y = pk2(k0.z, k0.w); o.z = pk2(k1.x, k1.y); o.w = pk2(k1.z, k1.w);
        *(GAS v4u*)((bf16*)(ws + WS_KEYS) + (size_t)g8 * 8) = o;
    }
    { const int gt = vcu * 512 + tid;
      if (gt < 192 * 16) { const int idx = gt >> 4, j = gt & 15; const float pos = (float)(idx < 128 ? idx : idx - 128);
          const float inv = __builtin_amdgcn_exp2f(-(float)j * (13.287712379549449f / 16.0f)); const float ang = pos * inv;
          ((GAS float*)(ws + WS_ROPE))[2 * gt] = __cosf(ang); ((GAS float*)(ws + WS_ROPE))[2 * gt + 1] = __sinf(ang); } }
}

__device__ __forceinline__ void ph_wq8(unsigned char* ws, size_t src_off, size_t dst_off, size_t sc_off, int gw, int NGW, int lane) {
    for (int row = gw; row < DEPTH * 2048; row += NGW) {
        const bf16* src = (const bf16*)(ws + src_off) + (size_t)row * D + 16 * lane;
        float f0[8], f1[8]; unpack8(*(const GAS v4u*)src, f0); unpack8(*(const GAS v4u*)(src + 8), f1);
        float mx = 0.f;
#pragma unroll
        for (int i = 0; i < 8; ++i) mx = fmaxf(mx, fmaxf(fabsf(f0[i]), fabsf(f1[i])));
        mx = fmaxf(wave_max(mx), 1e-30f); const float inv = 127.0f * __builtin_amdgcn_rcpf(mx);
        v4u o;
#pragma unroll
        for (int j = 0; j < 4; ++j) { unsigned w = 0;
#pragma unroll
            for (int i = 0; i < 4; ++i) { int q = (int)rintf((j < 2 ? f0[4 * j + i] : f1[4 * (j - 2) + i]) * inv); q = q < -127 ? -127 : (q > 127 ? 127 : q); w |= (unsigned)(q & 255) << (8 * i); }
            o[j] = w; }
        *(GAS v4u*)(ws + dst_off + (size_t)row * D + 16 * lane) = o;
        if (lane == 0) ((GAS float*)(ws + sc_off))[row] = mx * (1.0f / 127.0f);
    }
}
__device__ __forceinline__ void norm_row_store(const f32x4 (&v)[4], float rs, const float* g, const float* sc, const float* sh, bf16* dst, int lane) {
#pragma unroll
    for (int j = 0; j < 4; ++j) { const int c = 4 * lane + 256 * j;
        const f32x4 g4 = *(const GAS f32x4*)(g + c), s4 = *(const GAS f32x4*)(sc + c), h4 = *(const GAS f32x4*)(sh + c);
        const f32x4 o = v[j] * rs * g4 * (s4 + 1.0f) + h4;
        *(GAS unsigned long long*)(dst + c) = (unsigned long long)pk2(o.x, o.y) | ((unsigned long long)pk2(o.z, o.w) << 32); }
}
__device__ __forceinline__ int ncol(int lane, int q) { return 8 * lane + 512 * (q >> 1) + 4 * (q & 1); }
struct NormMods { f32x4 gw[4], sh[4]; };
__device__ __forceinline__ void load_mods(NormMods& M, const float* g, const float* mm, int shift_idx, int scale_idx, int lane) {
#pragma unroll
    for (int j = 0; j < 4; ++j) { const int c = ncol(lane, j); M.gw[j] = *(const GAS f32x4*)(g + c) * (*(const GAS f32x4*)(mm + scale_idx * D + c) + 1.0f); M.sh[j] = *(const GAS f32x4*)(mm + shift_idx * D + c); }
}
__device__ __forceinline__ void norm_one(const f32x4 (&v)[4], int r, const NormMods& M, bf16* XN, signed char* h8, float* hsc, int lane) {
    float ss = 0.f;
#pragma unroll
    for (int j = 0; j < 4; ++j) ss += (v[j].x * v[j].x + v[j].y * v[j].y) + (v[j].z * v[j].z + v[j].w * v[j].w);
    const float rs = __builtin_amdgcn_rsqf(wave_sum(ss) * (1.0f / D) + EPS);
    f32x4 o[4]; float mx = 0.f;
#pragma unroll
    for (int j = 0; j < 4; ++j) { o[j] = v[j] * rs * M.gw[j] + M.sh[j]; mx = fmaxf(mx, fmaxf(fmaxf(fabsf(o[j].x), fabsf(o[j].y)), fmaxf(fabsf(o[j].z), fabsf(o[j].w)))); }
    if (!h8) {
        mx = fmaxf(wave_max(mx), 1e-30f); const float inv = 127.0f * __builtin_amdgcn_rcpf(mx);
#pragma unroll
        for (int j = 0; j < 2; ++j) { unsigned long long w8 = 0ull;
#pragma unroll
            for (int n = 0; n < 8; ++n) { int q = (int)rintf(o[2 * j + (n >> 2)][n & 3] * inv); q = q < -127 ? -127 : (q > 127 ? 127 : q); w8 |= (unsigned long long)(unsigned)(q & 255) << (8 * n); }
            *(GAS unsigned long long*)((signed char*)XN + (size_t)r * D + 8 * lane + 512 * j) = w8; }
        if (lane == 0) ((GAS float*)hsc)[r] = mx * (1.0f / 127.0f);
    }
    if (h8) {
        mx = fmaxf(wave_max(mx), 1e-30f); const float inv = 119.0f * __builtin_amdgcn_rcpf(mx);
#pragma unroll
        for (int j = 0; j < 2; ++j) { unsigned wa = 0, wb = 0;
            unsigned long long w8 = 0ull;
#pragma unroll
            for (int n = 0; n < 8; ++n) { int q = (int)rintf(o[2 * j + (n >> 2)][n & 3] * inv); q = q < -119 ? -119 : (q > 119 ? 119 : q);
                const int bl = ((q + 8) & 15) - 8, ah = (q - bl) >> 4; wa |= (unsigned)(ah & 15) << (4 * n); wb |= (unsigned)(bl & 15) << (4 * n); w8 |= (unsigned long long)(unsigned)(q & 255) << (8 * n); }
            *(GAS unsigned*)(h8 + (size_t)r * D + 4 * lane + 256 * j) = wa; *(GAS unsigned*)(h8 + (size_t)r * D + 512 + 4 * lane + 256 * j) = wb;
            *(GAS unsigned long long*)((signed char*)XN + (size_t)r * D + 8 * lane + 512 * j) = w8; }
        if (lane == 0) ((GAS float*)hsc)[r] = mx * (1.0f / 119.0f);
    }
}
__device__ __forceinline__ void load_row4(const float* src_c, const float* src_l, const bf16* X, int r, int lane, f32x4 (&v)[4]) {
    if (X) {
#pragma unroll
        for (int j = 0; j < 2; ++j) { const v4u w = *(const GAS v4u*)(X + (size_t)r * D + 8 * lane + 512 * j);
            v[2 * j] = (f32x4){bflo(w.x), bfhi(w.x), bflo(w.y), bfhi(w.y)}; v[2 * j + 1] = (f32x4){bflo(w.z), bfhi(w.z), bflo(w.w), bfhi(w.w)}; }
    } else { const float* x = r < R_CTX ? src_c + (size_t)r * D : src_l + (size_t)(r - R_CTX) * D;
#pragma unroll
        for (int j = 0; j < 4; ++j) v[j] = *(const GAS f32x4*)(x + ncol(lane, j)); }
}
__device__ __forceinline__ void ph_norm(const float* src_c, const float* src_l, const bf16* X, const float* g, const float* modsL, int shift_idx, int scale_idx, bf16* XN, signed char* h8, float* hsc, int row_lo, int gw, int NGW, int lane) {
    for (int r = row_lo + gw; r < R; r += 4 * NGW) {
        const int rr[4] = {r, r + NGW, r + 2 * NGW, r + 3 * NGW};
        f32x4 v0[4], v1[4], v2[4], v3[4];
        load_row4(src_c, src_l, X, r, lane, v0); load_row4(src_c, src_l, X, rr[1] < R ? rr[1] : r, lane, v1); load_row4(src_c, src_l, X, rr[2] < R ? rr[2] : r, lane, v2); load_row4(src_c, src_l, X, rr[3] < R ? rr[3] : r, lane, v3);
        int mb = row_modb(r); NormMods M; load_mods(M, g, modsL + (size_t)mb * NMOD, shift_idx, scale_idx, lane);
        norm_one(v0, r, M, XN, h8, hsc, lane);
        if (rr[1] < R) { const int m2 = row_modb(rr[1]); if (m2 != mb) { mb = m2; load_mods(M, g, modsL + (size_t)mb * NMOD, shift_idx, scale_idx, lane); } norm_one(v1, rr[1], M, XN, h8, hsc, lane); }
        if (rr[2] < R) { const int m2 = row_modb(rr[2]); if (m2 != mb) { mb = m2; load_mods(M, g, modsL + (size_t)mb * NMOD, shift_idx, scale_idx, lane); } norm_one(v2, rr[2], M, XN, h8, hsc, lane); }
        if (rr[3] < R) { const int m2 = row_modb(rr[3]); if (m2 != mb) { mb = m2; load_mods(M, g, modsL + (size_t)mb * NMOD, shift_idx, scale_idx, lane); } norm_one(v3, rr[3], M, XN, h8, hsc, lane); }
    }
}
__device__ __forceinline__ void ph_final(const bf16* X, float* out, const float* fg, int gw, int NGW, int lane) {
    f32x4 g4[4];
#pragma unroll
    for (int j = 0; j < 4; ++j) g4[j] = *(const GAS f32x4*)(fg + ncol(lane, j));
    for (int r = gw; r < R_LAT; r += 4 * NGW) {
        f32x4 v[4][4];
#pragma unroll
        for (int q = 0; q < 4; ++q) load_row4(nullptr, nullptr, X, R_CTX + (r + q * NGW < R_LAT ? r + q * NGW : r), lane, v[q]);
#pragma unroll
        for (int q = 0; q < 4; ++q) { const int rq = r + q * NGW; if (rq < R_LAT) { float ss = 0.f;
#pragma unroll
            for (int j = 0; j < 4; ++j) ss += (v[q][j].x * v[q][j].x + v[q][j].y * v[q][j].y) + (v[q][j].z * v[q][j].z + v[q][j].w * v[q][j].w);
            const float rs = __builtin_amdgcn_rsqf(wave_sum(ss) * (1.0f / D) + EPS); float* x = out + (size_t)rq * D;
#pragma unroll
            for (int j = 0; j < 4; ++j) *(GAS f32x4*)(x + ncol(lane, j)) = v[q][j] * rs * g4[j]; } }
    }
}
typedef short s16x4p __attribute__((ext_vector_type(4)));
__device__ __forceinline__ s16x4p vtr_p(const LAS unsigned char* p) { return __builtin_bit_cast(s16x4p, __builtin_amdgcn_ds_read_tr16_b64_v4i16((LAS s16x4p*)p)); }
constexpr int SG_VP = 544, SG_SP = 528;
__device__ __forceinline__ void post_conv_item(const bf16* P, bf16* Y, const float* cw, int r, int grp) {
    const bool isc = r < R_CTX; const int t = row_t(r), len = isc ? CTXL : SEQ;
    const bf16* p = P + (size_t)r * D_IN + grp * 8;
    const bool h0 = t > 0, h2 = t < len - 1;
    const v4u z4 = (v4u){0u, 0u, 0u, 0u};
    const v4u wb = *(const GAS v4u*)(p + C_CONVB), wc1 = *(const GAS v4u*)(p + C_CONVC), wx1 = *(const GAS v4u*)(p + C_CONVX);
    const v4u wc0 = h0 ? *(const GAS v4u*)(p - D_IN + C_CONVC) : z4, wx0 = h0 ? *(const GAS v4u*)(p - D_IN + C_CONVX) : z4;
    const v4u wc2 = h2 ? *(const GAS v4u*)(p + D_IN + C_CONVC) : z4, wx2 = h2 ? *(const GAS v4u*)(p + D_IN + C_CONVX) : z4;
    float b[8], c1[8], x1[8], c0[8], x0[8], c2[8], x2[8];
    unpack8(wb, b); unpack8(wc1, c1); unpack8(wx1, x1); unpack8(wc0, c0); unpack8(wx0, x0); unpack8(wc2, c2); unpack8(wx2, x2);
    float y[8]; float ss = 0.f;
#pragma unroll
    for (int e = 0; e < 8; ++e) { const int cc = grp * 8 + e; y[e] = b[e] * (c0[e] * x0[e] * cw[cc] + c1[e] * x1[e] * cw[256 + cc] + c2[e] * x2[e] * cw[512 + cc]); ss += y[e] * y[e]; }
    const float rs = __builtin_amdgcn_rsqf(half_sum32(ss) * (1.0f / 256.0f) + EPS);
#pragma unroll
    for (int e = 0; e < 8; ++e) y[e] *= rs;
    *(GAS v4u*)(Y + (size_t)r * D + grp * 8) = pack8(y);
}
__device__ __forceinline__ void post_qkv_item(const bf16* P, bf16* Qb, bf16* Kb, bf16* Vb, const float* rope, int r, int it, bool skipq) {
    const bool isc = r < R_CTX; const bf16* p = P + (size_t)r * D_IN;
    if (it < 40) {
        const int head = it >> 2, sub = it & 3, d0 = (sub & 1) * 8 + (sub >> 1) * 32;
        if (head < 8 && skipq) return;
        const bf16* src = p + (head < 8 ? C_Q + head * 64 : C_K + (head - 8) * 64) + d0;
        float x[8], y[8]; unpack8(*(const GAS v4u*)src, x); unpack8(*(const GAS v4u*)(src + 16), y);
        float oa[8], ob[8];
        if (!isc) { const int t = (r - R_CTX) & 8191; const int ti = (sub >> 1) ? 128 + (t & 63) : (t >> 6);
            const float* tb = rope + ((size_t)ti * 16 + (sub & 1) * 8) * 2;
#pragma unroll
            for (int e = 0; e < 8; e += 2) { const f32x4 cs4 = *(const GAS f32x4*)(tb + 2 * e);
                oa[e] = x[e] * cs4.x - y[e] * cs4.y; ob[e] = y[e] * cs4.x + x[e] * cs4.y; oa[e + 1] = x[e + 1] * cs4.z - y[e + 1] * cs4.w; ob[e + 1] = y[e + 1] * cs4.z + x[e + 1] * cs4.w; } }
        else {
#pragma unroll
            for (int e = 0; e < 8; ++e) { oa[e] = x[e]; ob[e] = y[e]; } }
        if (head < 8) {
#pragma unroll
            for (int e = 0; e < 8; ++e) { oa[e] *= QSCALE; ob[e] *= QSCALE; }
            bf16* dst = Qb + (size_t)r * 512 + head * 64 + d0; *(GAS v4u*)dst = pack8(oa); *(GAS v4u*)(dst + 16) = pack8(ob);
        } else { bf16* dst = Kb + (size_t)r * 128 + (head - 8) * 64 + d0; *(GAS v4u*)dst = pack8(oa); *(GAS v4u*)(dst + 16) = pack8(ob); }
    } else {
        const int g = it - 40; const bf16* src = p + C_V + g * 16; bf16* dst = Vb + (size_t)r * 128 + g * 16;
        const v4u v0 = *(const GAS v4u*)src, v1 = *(const GAS v4u*)(src + 8); *(GAS v4u*)dst = v0; *(GAS v4u*)(dst + 8) = v1;
    }
}
__device__ __forceinline__ void ph_post(const Args& a, int layer, bool last, LAS unsigned char* L, int tid, int lane, int wave, int vcu, int G) {
    unsigned char* ws = a.ws;
    const bf16* P = (const bf16*)(ws + WS_P); bf16* Y = (bf16*)(ws + WS_Y); bf16* Qb = (bf16*)(ws + WS_Q); bf16* Kb = (bf16*)(ws + WS_K); bf16* Vb = (bf16*)(ws + WS_V);
    const float* cw = a.in[I_CONVW] + layer * 3 * 256; const float* gn = a.in[I_SGUG] + layer * 256;
    const bf16* sw = (const bf16*)(ws + WS_SGUW) + (size_t)layer * 4 * 128 * 128; const float* sb = a.in[I_SGUB] + layer * 4 * 128;
    const float* rope = (const float*)(ws + WS_ROPE);
    const int rlo2 = last ? R_CTX : 0;
    LAS unsigned char* vbuf = L; LAS unsigned char* sbuf = L + 128 * SG_VP;
    for (int ch = rlo2 / 128 + vcu; ch < R / 128; ch += G) {
        const int r0 = ch * 128;
        bf16x8 afr[4][4];
        { const int hh = wave >> 1, ph = wave & 1, n = lane & 15, kg = lane >> 4; const bf16* wp = sw + ((size_t)hh * 128 + 64 * ph + n) * 128 + 8 * kg;
#pragma unroll
          for (int ks = 0; ks < 4; ++ks)
#pragma unroll
              for (int m = 0; m < 4; ++m) afr[ks][m] = *(const GAS bf16x8*)(wp + (size_t)(16 * m) * 128 + 32 * ks); }
        { v4u vin[8];
#pragma unroll
          for (int i = 0; i < 8; ++i) { const int idx = tid + 512 * i; vin[i] = *(const GAS v4u*)(P + (size_t)(r0 + (idx >> 5)) * D_IN + C_SGUV + (idx & 31) * 8); }
#pragma unroll
          for (int i = 0; i < 8; ++i) { const int idx = tid + 512 * i, row = idx >> 5, grp = idx & 31;
              float v[8]; unpack8(vin[i], v); float s = 0.f;
#pragma unroll
              for (int e = 0; e < 8; ++e) { v[e] = gelu_tanh(v[e]); s += v[e]; }
              const float mu = half_sum32(s) * (1.0f / 256.0f); float q = 0.f;
#pragma unroll
              for (int e = 0; e < 8; ++e) { v[e] -= mu; q += v[e] * v[e]; }
              const float rs = __builtin_amdgcn_rsqf(half_sum32(q) * (1.0f / 256.0f) + EPS);
#pragma unroll
              for (int e = 0; e < 8; ++e) v[e] = v[e] * rs * gn[grp * 8 + e];
              *(LAS v4u*)(vbuf + row * SG_VP + grp * 16) = pack8(v); } }
        __syncthreads();
        { const int hh = wave >> 1, ph = wave & 1, n = lane & 15, kg = lane >> 4;
          f32x4 acc[4][4];
#pragma unroll
          for (int m = 0; m < 4; ++m)
#pragma unroll
              for (int ct = 0; ct < 4; ++ct) acc[m][ct] = (f32x4){0.f, 0.f, 0.f, 0.f};
          const LAS unsigned char* vb = vbuf + (8 * kg + (n >> 2)) * SG_VP + (hh * 64 + 4 * (n & 3)) * 2;
#pragma unroll
          for (int ks = 0; ks < 4; ++ks) {
              bf16x8 bfr[4];
#pragma unroll
              for (int ct = 0; ct < 4; ++ct) { const s16x4p lo = vtr_p(vb + (32 * ks) * SG_VP + ct * 32), hi4 = vtr_p(vb + (32 * ks + 4) * SG_VP + ct * 32);
                  bfr[ct] = (bf16x8){lo[0], lo[1], lo[2], lo[3], hi4[0], hi4[1], hi4[2], hi4[3]}; }
#pragma unroll
              for (int m = 0; m < 4; ++m)
#pragma unroll
                  for (int ct = 0; ct < 4; ++ct) acc[m][ct] = __builtin_amdgcn_mfma_f32_16x16x32_bf16(afr[ks][m], bfr[ct], acc[m][ct], 0, 0, 0);
          }
#pragma unroll
          for (int m = 0; m < 4; ++m) { const int pb = 64 * ph + 16 * m + 4 * kg; const f32x4 bias = *(const GAS f32x4*)(sb + hh * 128 + pb);
#pragma unroll
              for (int ct = 0; ct < 4; ++ct)
#pragma unroll
                  for (int e = 0; e < 4; ++e) *(LAS unsigned short*)(sbuf + (pb + e) * SG_SP + (hh * 64 + 16 * ct + n) * 2) = (unsigned short)f2bf(acc[m][ct][e] + bias[e]); } }
        __syncthreads();
        { v4u uin[8];
#pragma unroll
          for (int i = 0; i < 8; ++i) { const int idx = tid + 512 * i; uin[i] = *(const GAS v4u*)(P + (size_t)(r0 + (idx >> 5)) * D_IN + C_SGUU + (idx & 31) * 8); }
#pragma unroll
          for (int i = 0; i < 8; ++i) { const int idx = tid + 512 * i, row = idx >> 5, grp = idx & 31;
              float u[8], s8[8]; unpack8(uin[i], u); unpack8(*(const LAS v4u*)(sbuf + row * SG_SP + grp * 16), s8); float ss = 0.f;
#pragma unroll
              for (int e = 0; e < 8; ++e) { u[e] = gelu_tanh(u[e]) * s8[e]; ss += u[e] * u[e]; }
              const float rs = __builtin_amdgcn_rsqf(half_sum32(ss) * (1.0f / 256.0f) + EPS);
#pragma unroll
              for (int e = 0; e < 8; ++e) u[e] *= rs;
              *(GAS v4u*)(Y + (size_t)(r0 + row) * D + 256 + grp * 8) = pack8(u); } }
        __syncthreads();
    }
    { const int nch = (R - rlo2) / 128, nh0 = (nch > G && nch < 2 * G && 4 * (nch - G) < G) ? nch - G : 0, nh = (nh0 > 0 && !last && G >= 64) ? 40 : nh0;
      const int nit = (R - rlo2) * 32, gt = (vcu - nh) * 512 + tid, GT = (G - nh) * 512;
      if (vcu >= nh)
      for (int it = gt; it < nit; it += 4 * GT) {
#pragma unroll
          for (int q = 0; q < 4; ++q) { const int i2 = it + q * GT; if (i2 < nit) post_conv_item(P, Y, cw, rlo2 + (i2 >> 5), i2 & 31); } } }
}

__device__ __forceinline__ void ph_attn_simple(const Args& a, int layer, int row_lo, LAS unsigned char* L, int lane, int wave, int gw, int NGW) {
    unsigned char* ws = a.ws;
    const bf16* Qb = (const bf16*)(ws + WS_Q); const bf16* Kb = (const bf16*)(ws + WS_K); const bf16* Vb = (const bf16*)(ws + WS_V);
    bf16* Y = (bf16*)(ws + WS_Y); float* ssq = (float*)(ws + WS_SSQ);
    LAS float* pb = (LAS float*)(L + wave * 2560);
    const int nitems = (R - row_lo) * 8;
    for (int item = gw; item < nitems; item += NGW) {
        const int r = row_lo + (item >> 3), head = item & 7, kvh = head >> 2;
#ifdef EXP_EDGE
        { const int tq = r >= R_CTX ? ((r - R_CTX) & 8191) >> 6 : -1; if (tq >= 2 && tq <= 125) continue; }
#endif
        const bool lat = r >= R_CTX; const int b = lat ? ((r - R_CTX) >> 13) : (r >> 8);
        const int cbase = b * CTXL; int lo = 0, nloc = 0;
        if (lat) { const int t = (r - R_CTX) & 8191; const int tlo = t - 128 < 0 ? 0 : t - 128, thi = t + 128 > SEQ - 1 ? SEQ - 1 : t + 128; lo = r - (t - tlo); nloc = thi - tlo + 1; }
        const int nk = CTXL + nloc;
        float q[64];
        { const bf16* qp = Qb + (size_t)r * 512 + head * 64;
#pragma unroll
          for (int k8 = 0; k8 < 8; ++k8) { float f[8]; unpack8(*(const GAS v4u*)(qp + k8 * 8), f);
#pragma unroll
              for (int e = 0; e < 8; ++e) q[k8 * 8 + e] = f[e]; } }
        const float sink2 = a.in[I_SINK][layer * 8 + head] * LOG2E;
        float mx = sink2;
        for (int i = lane; i < nk; i += 64) {
            const int kr = i < CTXL ? cbase + i : lo + (i - CTXL);
            const bf16* kp = Kb + (size_t)kr * 128 + kvh * 64; float s = 0.f;
#pragma unroll
            for (int k8 = 0; k8 < 8; ++k8) { float f[8]; unpack8(*(const GAS v4u*)(kp + k8 * 8), f);
#pragma unroll
                for (int e = 0; e < 8; ++e) s += q[k8 * 8 + e] * f[e]; }
            pb[i] = s; mx = fmaxf(mx, s);
        }
        mx = wave_max(mx); float den = 0.f;
        for (int i = lane; i < nk; i += 64) { const float e = exp2f(pb[i] - mx); pb[i] = e; den += e; }
        den = wave_sum(den) + exp2f(sink2 - mx);
        LDS_WAIT();
        float o = 0.f;
        for (int i = 0; i < nk; ++i) { const int kr = i < CTXL ? cbase + i : lo + (i - CTXL); o += pb[i] * bf2f(Vb[(size_t)kr * 128 + kvh * 64 + lane]); }
        o /= den;
        Y[(size_t)r * D + 512 + head * 64 + lane] = (bf16)f2bf(o);
        const float s2 = wave_sum(o * o);
        if (lane == 0) ssq[(size_t)r * 8 + head] = s2;
        LDS_WAIT();
    }
}
__device__ __forceinline__ void ph_attn_norm(const Args& a, int row_lo, int lane, int gw, int NGW) {
    bf16* Y = (bf16*)(a.ws + WS_Y); const float* ssq = (const float*)(a.ws + WS_SSQ);
    for (int r = row_lo + gw; r < R; r += NGW) {
        const f32x4 s0 = *(const GAS f32x4*)(ssq + (size_t)r * 8), s1 = *(const GAS f32x4*)(ssq + (size_t)r * 8 + 4);
        const float rs = __builtin_amdgcn_rsqf(((s0.x + s0.y) + (s0.z + s0.w) + (s1.x + s1.y) + (s1.z + s1.w)) * (1.0f / 512.0f) + EPS);
        bf16* y = Y + (size_t)r * D + 512 + lane * 8; float f[8]; unpack8(*(const GAS v4u*)y, f);
#pragma unroll
        for (int e = 0; e < 8; ++e) f[e] *= rs;
        *(GAS v4u*)y = pack8(f);
    }
}

__device__ __forceinline__ void ph_topk_simple(const Args& a, int layer, int row_lo, LAS unsigned char* L, int tid, int vcu, int G) {
    const bf16* QP = (const bf16*)(a.ws + WS_P); int* eidx = (int*)(a.ws + WS_EIDX); float* egate = (float*)(a.ws + WS_GATE);
    const float* keys = a.in[I_KEYS] + (size_t)layer * 8 * 2 * 128 * 128;
    const int hw = tid >> 8, t = tid & 255, p = t >> 7, k = t & 127;
    LAS float* qs = (LAS float*)(L + hw * 4096); LAS float* sc = qs + 256; LAS float* cand = sc + 256; LAS float* sv = cand + 256; LAS int* si = (LAS int*)(sv + 32); LAS float* fv = (LAS float*)(si + 32); LAS int* fe = (LAS int*)(fv + 16);
    const int nitems = (R - row_lo) * 8, NVB = 2 * G, iters = (nitems + NVB - 1) / NVB;
    for (int itn = 0; itn < iters; ++itn) {
        const int item = itn * NVB + vcu * 2 + hw; const bool act = item < nitems;
        const int r = row_lo + (act ? item >> 3 : 0), h = item & 7;
        qs[t] = bf2f(QP[(size_t)r * 2048 + h * 256 + t]);
        __syncthreads();
        { const float* kp = keys + (((size_t)h * 2 + p) * 128 + k) * 128; float s = 0.f;
#pragma unroll 8
          for (int d = 0; d < 128; d += 4) { const f32x4 kv = *(const GAS f32x4*)(kp + d); s += qs[p * 128 + d] * kv.x + qs[p * 128 + d + 1] * kv.y + qs[p * 128 + d + 2] * kv.z + qs[p * 128 + d + 3] * kv.w; }
          sc[t] = s; }
        __syncthreads();
        { const float my = sc[t]; int rank = 0;
          for (int j = 0; j < 128; ++j) { const float o = sc[p * 128 + j]; rank += (o > my || (o == my && j < k)) ? 1 : 0; }
          if (rank < 16) { sv[p * 16 + rank] = my; si[p * 16 + rank] = k; } }
        __syncthreads();
        cand[t] = sv[t >> 4] + sv[16 + (t & 15)];
        __syncthreads();
        { const float my = cand[t]; int rank = 0;
          for (int j = 0; j < 256; ++j) { const float o = cand[j]; rank += (o > my || (o == my && j < t)) ? 1 : 0; }
          if (rank < 16) { fv[rank] = my; fe[rank] = si[t >> 4] * 128 + si[16 + (t & 15)]; } }
        __syncthreads();
        if (t < 16 && act) { const float m = fv[0]; float den = 0.f;
#pragma unroll
            for (int j = 0; j < 16; ++j) den += __expf(fv[j] - m);
            eidx[(size_t)r * 128 + h * 16 + t] = fe[t]; egate[(size_t)r * 128 + h * 16 + t] = __expf(fv[t] - m) / den; }
        __syncthreads();
    }
}

typedef float f32x16 __attribute__((ext_vector_type(16)));
typedef short s16x4 __attribute__((ext_vector_type(4)));
typedef float f32x2_t __attribute__((ext_vector_type(2))); typedef __bf16 bf16x2_t __attribute__((ext_vector_type(2)));
__device__ __forceinline__ unsigned cvtpk(float lo, float hi) { f32x2_t v = {lo, hi}; bf16x2_t b = __builtin_convertvector(v, bf16x2_t); return __builtin_bit_cast(unsigned, b); }
__device__ __forceinline__ int crow(int r, int hi) { return (r & 3) + 8 * (r >> 2) + 4 * hi; }
__device__ __forceinline__ s16x4 vtr(const LAS unsigned char* p) { return __builtin_bit_cast(s16x4, __builtin_amdgcn_ds_read_tr16_b64_v4i16((LAS s16x4*)p)); }
__device__ __forceinline__ unsigned xhalf_other_u(unsigned v, int hi) { unsigned a_ = v, b_ = v; asm volatile("" : "+v"(a_), "+v"(b_)); auto rr = __builtin_amdgcn_permlane32_swap(a_, b_, false, false); return hi ? rr[0] : rr[1]; }
__device__ __forceinline__ float xhalf_max(float m, int hi) { return fmaxf(m, __builtin_bit_cast(float, xhalf_other_u(__builtin_bit_cast(unsigned, m), hi))); }
__device__ __forceinline__ float xhalf_sum(float m, int hi) { return m + __builtin_bit_cast(float, xhalf_other_u(__builtin_bit_cast(unsigned, m), hi)); }
constexpr int AT_ROWB = 144;
__device__ __forceinline__ void ph_attn(const Args& a, int layer, bool last, LAS unsigned char* L, int tid, int lane, int wave, int vcu, int G) {
    unsigned char* ws = a.ws;
    const bf16* Qb = (const bf16*)(ws + WS_Q); const bf16* Kb = (const bf16*)(ws + WS_K); const bf16* Vb = (const bf16*)(ws + WS_V);
    bf16* Y = (bf16*)(ws + WS_Y); float* ssq = (float*)(ws + WS_SSQ);
    const int hi = lane >> 5, l31 = lane & 31;
    constexpr int AT_BUF = 2 * 64 * AT_ROWB;
    LAS float* wsf = (LAS float*)(L + 2 * AT_BUF + wave * 256);
    LAS unsigned char* stg = L + 2 * AT_BUF + 8 * 256 + wave * (32 * AT_ROWB);
    const bool remap = !last && G >= 64; bool ctxdone = false;
    const int nunits = 1024 + ((last || remap) ? 0 : 32);
    const int ldrow = tid >> 3, ldch = tid & 7;
    for (int u = vcu; ; u += G) {
        if (u >= nunits) { if (!remap || ctxdone || vcu < 8 || vcu >= 40) break; u = 1024 + vcu - 8; ctxdone = true; }
        int b, qblk, kvh; bool isc;
        if (u < 1024) { isc = false; kvh = u & 1; qblk = (u >> 1) & 127; b = u >> 8; } else { const int v = u - 1024; isc = true; kvh = v & 1; qblk = (v >> 1) & 3; b = v >> 3; }
#ifdef EXP_EDGE
        if (isc || qblk < 2 || qblk > 125) continue;
#endif
        const int qrow0 = isc ? b * CTXL + qblk * 64 : R_CTX + b * SEQ + qblk * 64;
        const int hq = kvh * 4 + (wave >> 1), qsub = wave & 1;
        const int lo_off = qblk < 2 ? -qblk : -2, hi_off = qblk > 125 ? 127 - qblk : 2;
        const int nt = isc ? 4 : 4 + (hi_off - lo_off + 1);
        bf16x8 qr[4];
        { const bf16* qp = Qb + (size_t)(qrow0 + 32 * qsub + l31) * 512 + hq * 64 + 8 * hi;
#pragma unroll
          for (int d0 = 0; d0 < 4; ++d0) qr[d0] = *(const GAS bf16x8*)(qp + 16 * d0); }
        const float sink2 = a.in[I_SINK][layer * 8 + hq] * LOG2E;
        float mrun = sink2, lrun = hi == 0 ? 1.0f : 0.0f;
        f32x16 o0 = {}, o1 = {};
        v4u kreg, vreg;
        { const int kr = b * CTXL + ldrow;
          kreg = *(const GAS v4u*)(Kb + (size_t)kr * 128 + kvh * 64 + ldch * 8); vreg = *(const GAS v4u*)(Vb + (size_t)kr * 128 + kvh * 64 + ldch * 8); }
#define AT_LOADT(TN) { const int tn_ = (TN); const int kr_ = (tn_ < 4 ? b * CTXL + 64 * tn_ : R_CTX + b * SEQ + 64 * (qblk + lo_off + tn_ - 4)) + ldrow; \
            kreg = *(const GAS v4u*)(Kb + (size_t)kr_ * 128 + kvh * 64 + ldch * 8); vreg = *(const GAS v4u*)(Vb + (size_t)kr_ * 128 + kvh * 64 + ldch * 8); }
        __syncthreads();
        *(LAS v4u*)(L + ldrow * AT_ROWB + ldch * 16) = kreg; *(LAS v4u*)(L + 64 * AT_ROWB + ldrow * AT_ROWB + ldch * 16) = vreg;
        if (1 < nt) AT_LOADT(1)
#pragma unroll 1
        for (int ti = 0; ti < nt; ++ti) {
            __syncthreads();
            LAS unsigned char* Ks = L + (ti & 1) * AT_BUF; LAS unsigned char* Vs = Ks + 64 * AT_ROWB;
            if (ti + 1 < nt) { LAS unsigned char* Kn = L + ((ti + 1) & 1) * AT_BUF;
                *(LAS v4u*)(Kn + ldrow * AT_ROWB + ldch * 16) = kreg; *(LAS v4u*)(Kn + 64 * AT_ROWB + ldrow * AT_ROWB + ldch * 16) = vreg;
                if (ti + 2 < nt) AT_LOADT(ti + 2) }
            const int off = ti < 4 ? 0 : lo_off + ti - 4; const int mtype = off == -2 ? 1 : (off == 2 ? 2 : 0);
            f32x16 p0 = {}, p1 = {};
#pragma unroll
            for (int d0 = 0; d0 < 4; ++d0) {
                const bf16x8 k0 = *(const LAS bf16x8*)(Ks + l31 * AT_ROWB + d0 * 32 + hi * 16);
                const bf16x8 k1 = *(const LAS bf16x8*)(Ks + (l31 + 32) * AT_ROWB + d0 * 32 + hi * 16);
                p0 = __builtin_amdgcn_mfma_f32_32x32x16_bf16(k0, qr[d0], p0, 0, 0, 0);
                p1 = __builtin_amdgcn_mfma_f32_32x32x16_bf16(k1, qr[d0], p1, 0, 0, 0);
            }
            if (mtype != 0) {
                int qi = 32 * qsub + l31; asm volatile("" : "+v"(qi));
#pragma unroll
                for (int r = 0; r < 16; ++r) { const int j0 = crow(r, hi), j1 = j0 + 32;
                    const bool ok0 = mtype == 1 ? (j0 >= qi) : (j0 <= qi), ok1 = mtype == 1 ? (j1 >= qi) : (j1 <= qi);
                    p0[r] = ok0 ? p0[r] : -INFINITY; p1[r] = ok1 ? p1[r] : -INFINITY; }
            }
            float mx = fmaxf(p0[0], p1[0]);
#pragma unroll
            for (int r = 1; r < 16; ++r) mx = fmaxf(mx, fmaxf(p0[r], p1[r]));
            mx = xhalf_max(mx, hi);
            const float mnew = fmaxf(mrun, mx), alpha = __builtin_amdgcn_exp2f(mrun - mnew); mrun = mnew;
            float rs = 0.f;
#pragma unroll
            for (int r = 0; r < 16; ++r) { p0[r] = __builtin_amdgcn_exp2f(p0[r] - mnew); p1[r] = __builtin_amdgcn_exp2f(p1[r] - mnew); rs += p0[r] + p1[r]; }
            lrun = lrun * alpha + rs;
            if (__builtin_amdgcn_ballot_w64(alpha != 1.0f) != 0ull) {
                if (hi == 0) wsf[l31] = alpha;
#pragma unroll
                for (int g = 0; g < 4; ++g) { const f32x4 al = *(const LAS f32x4*)(wsf + 8 * g + 4 * hi);
#pragma unroll
                    for (int e = 0; e < 4; ++e) { o0[4 * g + e] *= al[e]; o1[4 * g + e] *= al[e]; } }
            }
            const LAS unsigned char* vb = Vs + (4 * hi + ((lane & 15) >> 2)) * AT_ROWB + (16 * ((lane >> 4) & 1) + 4 * (lane & 3)) * 2;
#pragma unroll
            for (int half = 0; half < 2; ++half)
#pragma unroll
                for (int s = 0; s < 2; ++s) {
                    const f32x16& px = half ? p1 : p0;
                    v4u pw; pw.x = cvtpk(px[8 * s + 0], px[8 * s + 1]); pw.y = cvtpk(px[8 * s + 2], px[8 * s + 3]); pw.z = cvtpk(px[8 * s + 4], px[8 * s + 5]); pw.w = cvtpk(px[8 * s + 6], px[8 * s + 7]);
                    const bf16x8 pa = __builtin_bit_cast(bf16x8, pw);
                    const LAS unsigned char* vr = vb + (32 * half + 16 * s) * AT_ROWB;
                    const s16x4 a0 = vtr(vr), a1 = vtr(vr + 8 * AT_ROWB), b0 = vtr(vr + 64), b1 = vtr(vr + 8 * AT_ROWB + 64);
                    const bf16x8 v0 = (bf16x8){a0[0], a0[1], a0[2], a0[3], a1[0], a1[1], a1[2], a1[3]}, v1 = (bf16x8){b0[0], b0[1], b0[2], b0[3], b1[0], b1[1], b1[2], b1[3]};
                    o0 = __builtin_amdgcn_mfma_f32_32x32x16_bf16(pa, v0, o0, 0, 0, 0);
                    o1 = __builtin_amdgcn_mfma_f32_32x32x16_bf16(pa, v1, o1, 0, 0, 0);
                }
        }
        const float lt = xhalf_sum(lrun, hi);
        if (hi == 0) wsf[32 + l31] = __builtin_amdgcn_rcpf(lt);
#pragma unroll
        for (int g = 0; g < 4; ++g) { const f32x4 rl = *(const LAS f32x4*)(wsf + 32 + 8 * g + 4 * hi);
#pragma unroll
            for (int e = 0; e < 4; ++e) { const int qrow = 8 * g + 4 * hi + e;
                *(LAS unsigned short*)(stg + qrow * AT_ROWB + l31 * 2) = (unsigned short)f2bf(o0[4 * g + e] * rl[e]);
                *(LAS unsigned short*)(stg + qrow * AT_ROWB + (l31 + 32) * 2) = (unsigned short)f2bf(o1[4 * g + e] * rl[e]); } }
#pragma unroll
        for (int i = 0; i < 4; ++i) { const int row = i * 8 + (lane >> 3), ch = lane & 7; const v4u v = *(const LAS v4u*)(stg + row * AT_ROWB + ch * 16);
            const int rq = qrow0 + 32 * qsub + row;
            *(GAS v4u*)(Y + (size_t)rq * D + 512 + hq * 64 + ch * 8) = v;
            float f[8]; unpack8(v, f); float s2 = 0.f;
#pragma unroll
            for (int e = 0; e < 8; ++e) s2 += f[e] * f[e];
            s2 += dpp_f<0xB1>(s2); s2 += dpp_f<0x4E>(s2); s2 += dpp_f<0x141>(s2);
            if (ch == 0) ssq[(size_t)rq * 8 + hq] = s2; }
    }
}
#define SN_CE(a, b) { const float _hi = __builtin_amdgcn_fmed3f(a, b, kpi); b = __builtin_amdgcn_fmed3f(a, b, kni); a = _hi; }
__device__ __forceinline__ void sort16(float (&v)[16], float kpi, float kni) {
    SN_CE(v[0], v[1])
    SN_CE(v[2], v[3])
    SN_CE(v[4], v[5])
    SN_CE(v[6], v[7])
    SN_CE(v[8], v[9])
    SN_CE(v[10], v[11])
    SN_CE(v[12], v[13])
    SN_CE(v[14], v[15])
    SN_CE(v[0], v[2])
    SN_CE(v[1], v[3])
    SN_CE(v[4], v[6])
    SN_CE(v[5], v[7])
    SN_CE(v[8], v[10])
    SN_CE(v[9], v[11])
    SN_CE(v[12], v[14])
    SN_CE(v[13], v[15])
    SN_CE(v[1], v[2])
    SN_CE(v[5], v[6])
    SN_CE(v[9], v[10])
    SN_CE(v[13], v[14])
    SN_CE(v[0], v[4])
    SN_CE(v[1], v[5])
    SN_CE(v[2], v[6])
    SN_CE(v[3], v[7])
    SN_CE(v[8], v[12])
    SN_CE(v[9], v[13])
    SN_CE(v[10], v[14])
    SN_CE(v[11], v[15])
    SN_CE(v[2], v[4])
    SN_CE(v[3], v[5])
    SN_CE(v[10], v[12])
    SN_CE(v[11], v[13])
    SN_CE(v[1], v[2])
    SN_CE(v[3], v[4])
    SN_CE(v[5], v[6])
    SN_CE(v[9], v[10])
    SN_CE(v[11], v[12])
    SN_CE(v[13], v[14])
    SN_CE(v[0], v[8])
    SN_CE(v[1], v[9])
    SN_CE(v[2], v[10])
    SN_CE(v[3], v[11])
    SN_CE(v[4], v[12])
    SN_CE(v[5], v[13])
    SN_CE(v[6], v[14])
    SN_CE(v[7], v[15])
    SN_CE(v[4], v[8])
    SN_CE(v[5], v[9])
    SN_CE(v[6], v[10])
    SN_CE(v[7], v[11])
    SN_CE(v[2], v[4])
    SN_CE(v[3], v[5])
    SN_CE(v[6], v[8])
    SN_CE(v[7], v[9])
    SN_CE(v[10], v[12])
    SN_CE(v[11], v[13])
    SN_CE(v[1], v[2])
    SN_CE(v[3], v[4])
    SN_CE(v[5], v[6])
    SN_CE(v[7], v[8])
    SN_CE(v[9], v[10])
    SN_CE(v[11], v[12])
    SN_CE(v[13], v[14])
}
__device__ __forceinline__ void bmerge16(float (&v)[16], float kpi, float kni) {
    SN_CE(v[0], v[8])
    SN_CE(v[1], v[9])
    SN_CE(v[2], v[10])
    SN_CE(v[3], v[11])
    SN_CE(v[4], v[12])
    SN_CE(v[5], v[13])
    SN_CE(v[6], v[14])
    SN_CE(v[7], v[15])
    SN_CE(v[0], v[4])
    SN_CE(v[1], v[5])
    SN_CE(v[2], v[6])
    SN_CE(v[3], v[7])
    SN_CE(v[8], v[12])
    SN_CE(v[9], v[13])
    SN_CE(v[10], v[14])
    SN_CE(v[11], v[15])
    SN_CE(v[0], v[2])
    SN_CE(v[1], v[3])
    SN_CE(v[4], v[6])
    SN_CE(v[5], v[7])
    SN_CE(v[8], v[10])
    SN_CE(v[9], v[11])
    SN_CE(v[12], v[14])
    SN_CE(v[13], v[15])
    SN_CE(v[0], v[1])
    SN_CE(v[2], v[3])
    SN_CE(v[4], v[5])
    SN_CE(v[6], v[7])
    SN_CE(v[8], v[9])
    SN_CE(v[10], v[11])
    SN_CE(v[12], v[13])
    SN_CE(v[14], v[15])
}
__device__ __forceinline__ void topmerge16(float (&a)[16], const float (&b)[16], float kpi, float kni) {
#pragma unroll
    for (int i = 0; i < 16; ++i) a[i] = __builtin_amdgcn_fmed3f(a[i], b[15 - i], kpi);
    bmerge16(a, kpi, kni);
}
__device__ __forceinline__ int f2key(float f) { const int b = __builtin_bit_cast(int, f); return b ^ ((b >> 31) & 0x7fffffff); }
__device__ __forceinline__ float key2f(int k) { return __builtin_bit_cast(float, k ^ ((k >> 31) & 0x7fffffff)); }
__device__ __forceinline__ float xhalf_other(float v, int hi) { return __builtin_bit_cast(float, xhalf_other_u(__builtin_bit_cast(unsigned, v), hi)); }
__device__ __forceinline__ float mkkey(float f, int clr, int idx) { return __builtin_bit_cast(float, (__builtin_bit_cast(int, f) & ~clr) | idx); }
__device__ __forceinline__ int keyidx(float k, int m) { return __builtin_bit_cast(int, k) & m; }
__device__ __forceinline__ unsigned tab16(const unsigned (&T)[4], int a) {
    const unsigned sel = (unsigned)(a & 7);
    const unsigned x = __builtin_amdgcn_perm(T[1], T[0], sel), y = __builtin_amdgcn_perm(T[3], T[2], sel);
    return ((a & 8) ? y : x) & 255u;
}
constexpr int TK_KP = 272;
__device__ __forceinline__ void topk_half(const LAS unsigned char* kl, const bf16x8 (&qf)[8], int hi, int l31, float (&out)[16], float kpi, float kni) {
    f32x16 acc[4] = {};
    const LAS unsigned char* kp = kl + l31 * TK_KP + hi * 16;
    bf16x8 kfa[4], kfb[4];
#pragma unroll
    for (int kt = 0; kt < 4; ++kt) kfa[kt] = *(const LAS bf16x8*)(kp + kt * 32 * TK_KP);
#pragma unroll
    for (int s = 0; s < 8; s += 2) {
#pragma unroll
        for (int kt = 0; kt < 4; ++kt) kfb[kt] = *(const LAS bf16x8*)(kp + kt * 32 * TK_KP + 32 * (s + 1));
#pragma unroll
        for (int kt = 0; kt < 4; ++kt) acc[kt] = __builtin_amdgcn_mfma_f32_32x32x16_bf16(kfa[kt], qf[s], acc[kt], 0, 0, 0);
        if (s + 2 < 8) {
#pragma unroll
            for (int kt = 0; kt < 4; ++kt) kfa[kt] = *(const LAS bf16x8*)(kp + kt * 32 * TK_KP + 32 * (s + 2)); }
#pragma unroll
        for (int kt = 0; kt < 4; ++kt) acc[kt] = __builtin_amdgcn_mfma_f32_32x32x16_bf16(kfb[kt], qf[s + 1], acc[kt], 0, 0, 0);
    }
    float v0[16], v1[16], v2[16], v3[16];
#pragma unroll
    for (int rr = 0; rr < 16; ++rr) { const int ib = 127 - (rr & 3) - 8 * (rr >> 2) - 4 * hi;
        v0[rr] = mkkey(acc[0][rr], 127, ib); v1[rr] = mkkey(acc[1][rr], 127, ib - 32); v2[rr] = mkkey(acc[2][rr], 127, ib - 64); v3[rr] = mkkey(acc[3][rr], 127, ib - 96); }
    sort16(v0, kpi, kni); sort16(v1, kpi, kni); sort16(v2, kpi, kni); sort16(v3, kpi, kni);
    topmerge16(v0, v1, kpi, kni); topmerge16(v2, v3, kpi, kni); topmerge16(v0, v2, kpi, kni);
#pragma unroll
    for (int i = 0; i < 16; ++i) v1[i] = xhalf_other(v0[i], hi);
    topmerge16(v0, v1, kpi, kni);
#pragma unroll
    for (int i = 0; i < 16; ++i) out[i] = v0[i];
    __builtin_amdgcn_sched_barrier(0);
}
#define TK_LOADQ(QF, ROW, P) { const bf16* qp_ = QP + ((size_t)(((ROW) >> 5) * 8 + h) * 2 + (P)) * 4096 + 8 * lane; _Pragma("unroll") for (int s_ = 0; s_ < 8; ++s_) QF[s_] = *(const GAS bf16x8*)(qp_ + 512 * s_); }
__device__ __forceinline__ void ph_topk(const Args& a, int layer, int row_lo, LAS unsigned char* L, int tid, int lane, int wave, int vcu, int G) {
    unsigned char* ws = a.ws;
    const bf16* QP = (const bf16*)(ws + WS_P); unsigned short* eidx = (unsigned short*)(ws + WS_EIDX); float* egate = (float*)(ws + WS_GATE);
    const int hi = lane >> 5, l31 = lane & 31, h = vcu & 7;
    const int nwh = (G - h + 7) >> 3;
    { const bf16* KEYS = (const bf16*)(ws + WS_KEYS) + ((size_t)layer * 8 + h) * 2 * 128 * 128;
#pragma unroll
      for (int i = 0; i < 8; ++i) { const int idx = tid + 512 * i, row = idx >> 4, chn = idx & 15; *(LAS v4u*)(L + row * TK_KP + chn * 16) = *(const GAS v4u*)(KEYS + (size_t)row * 128 + chn * 8); }
      __syncthreads(); }
    const int ngroups = (R - row_lo) / 32, W = nwh * NWAVES, rounds = ngroups / W;
    int tailg = rounds * W + wave * nwh + (vcu >> 3); const int cnt = rounds + (tailg < ngroups ? 1 : 0);
    tailg -= rounds * W + (vcu >> 3) * NWAVES + wave;
#define TK_GRP(i) ((vcu >> 3) * NWAVES + wave + (i) * W + ((i) < rounds ? 0 : tailg))
    float kpi = __builtin_inff(), kni = -__builtin_inff(); asm volatile("" : "+s"(kpi), "+s"(kni));
    bf16x8 qa[8], qb[8];
    if (cnt > 0) TK_LOADQ(qa, row_lo + TK_GRP(0) * 32 + l31, 0)
#pragma unroll 1
    for (int gi = 0; gi < cnt; ++gi) {
        const int grp = TK_GRP(gi);
        const int r = row_lo + grp * 32 + l31;
        TK_LOADQ(qb, r, 1)
        float sv0[16], sv1[16];
        topk_half(L, qa, hi, l31, sv0, kpi, kni);
        { const int gn = gi + 1 < cnt ? TK_GRP(gi + 1) : grp; const int rn = row_lo + gn * 32 + l31; TK_LOADQ(qa, rn, 0) }
        topk_half(L + 128 * TK_KP, qb, hi, l31, sv1, kpi, kni);
#define CANDK(aa, bb) mkkey(sv0[aa] + sv1[bb], 255, 255 - ((aa) * 16 + (bb)))
        const float NEGINF = -__builtin_inff();
        float c0[16], c1[16], c2[16], c3[16];
#pragma unroll
        for (int i = 0; i < 16; ++i) { c0[i] = CANDK(0, i); c1[i] = i < 8 ? CANDK(1, (i & 7)) : NEGINF; }
        c2[0] = CANDK(2, 0); c2[1] = CANDK(2, 1); c2[2] = CANDK(2, 2); c2[3] = CANDK(2, 3); c2[4] = CANDK(2, 4); c2[5] = CANDK(3, 0); c2[6] = CANDK(3, 1); c2[7] = CANDK(3, 2); c2[8] = CANDK(3, 3);
        c2[9] = CANDK(4, 0); c2[10] = CANDK(4, 1); c2[11] = CANDK(4, 2); c2[12] = CANDK(5, 0); c2[13] = CANDK(5, 1); c2[14] = CANDK(6, 0); c2[15] = CANDK(6, 1);
        c3[0] = CANDK(7, 0); c3[1] = CANDK(7, 1); c3[2] = CANDK(8, 0); c3[3] = CANDK(9, 0); c3[4] = CANDK(10, 0); c3[5] = CANDK(11, 0); c3[6] = CANDK(12, 0); c3[7] = CANDK(13, 0); c3[8] = CANDK(14, 0); c3[9] = CANDK(15, 0);
#pragma unroll
        for (int i = 10; i < 16; ++i) c3[i] = NEGINF;
#undef CANDK
        sort16(c2, kpi, kni); sort16(c3, kpi, kni);
        topmerge16(c0, c1, kpi, kni); topmerge16(c2, c3, kpi, kni); topmerge16(c0, c2, kpi, kni);
        float fv[16]; float den = 0.f;
#pragma unroll
        for (int i = 0; i < 16; ++i) { fv[i] = __expf(c0[i] - c0[0]); den += fv[i]; }
        const float rden = __builtin_amdgcn_rcpf(den);
        unsigned T0[4], T1[4];
#pragma unroll
        for (int w = 0; w < 4; ++w) {
            T0[w] = (unsigned)(127 - keyidx(sv0[4 * w], 127)) | ((unsigned)(127 - keyidx(sv0[4 * w + 1], 127)) << 8) | ((unsigned)(127 - keyidx(sv0[4 * w + 2], 127)) << 16) | ((unsigned)(127 - keyidx(sv0[4 * w + 3], 127)) << 24);
            T1[w] = (unsigned)(127 - keyidx(sv1[4 * w], 127)) | ((unsigned)(127 - keyidx(sv1[4 * w + 1], 127)) << 8) | ((unsigned)(127 - keyidx(sv1[4 * w + 2], 127)) << 16) | ((unsigned)(127 - keyidx(sv1[4 * w + 3], 127)) << 24);
        }
        int ev[8]; float gv[8];
#pragma unroll
        for (int i = 0; i < 8; ++i) { float ca = c0[i], cb = c0[8 + i]; float fa = fv[i], fb = fv[8 + i];
            asm volatile("" : "+v"(ca), "+v"(cb), "+v"(fa), "+v"(fb));
            const int ck = __builtin_bit_cast(int, hi ? cb : ca); const int id = 255 - (ck & 255);
            ev[i] = (int)(tab16(T0, id >> 4) * 128u + tab16(T1, id & 15)); gv[i] = (hi ? fb : fa) * rden; }
        unsigned short* ep = eidx + (size_t)r * 128 + h * 16 + 8 * hi; float* gp = egate + (size_t)r * 128 + h * 16 + 8 * hi;
        *(GAS v4u*)ep = (v4u){(unsigned)ev[0] | ((unsigned)ev[1] << 16), (unsigned)ev[2] | ((unsigned)ev[3] << 16), (unsigned)ev[4] | ((unsigned)ev[5] << 16), (unsigned)ev[6] | ((unsigned)ev[7] << 16)};
        *(GAS f32x4*)gp = (f32x4){gv[0], gv[1], gv[2], gv[3]}; *(GAS f32x4*)(gp + 4) = (f32x4){gv[4], gv[5], gv[6], gv[7]};
    }
}
struct XInfo { int pj, nx, nloc, rank; };
typedef float f32x2v __attribute__((ext_vector_type(2)));
__device__ __forceinline__ int red8_i(int v) { v += dpp_i<0xB1>(v); v += dpp_i<0x4E>(v); v += dpp_i<0x141>(v); return v; }
__device__ __forceinline__ unsigned id_of(const v4u& id0, const v4u& id1, int i) { const unsigned w = (i < 8 ? id0 : id1)[(i & 7) >> 1]; return (i & 1) ? (w >> 16) : (w & 0xffffu); }

#define PU_LOAD_RAW(T, IW, HW) { const int t_ = (T) < R ? (T) : row_lo; IW = *(const GAS unsigned*)(E + (size_t)t_ * 128 + 2 * lane); HW = *(const GAS unsigned*)(H8 + (size_t)t_ * D + hoff); }
#define PU_EXPAND(IW, HW, I0, I1, HA, HB) { _Pragma("unroll") for (int c = 0; c < 4; ++c) { I0[c] = (unsigned)__builtin_amdgcn_ds_bpermute(gb4 + 4 * c, (int)IW); I1[c] = (unsigned)__builtin_amdgcn_ds_bpermute(gb4 + 16 + 4 * c, (int)IW); \
    HA[c] = (unsigned)__builtin_amdgcn_ds_bpermute(jb4 + 4 * c, (int)HW); HB[c] = (unsigned)__builtin_amdgcn_ds_bpermute(jb4 + 128 + 4 * c, (int)HW); } }
#define PU_LOAD_ROWS(ROW, I0, I1) { _Pragma("unroll") for (int i = 0; i < 16; ++i) ROW[i] = *(const GAS v4u*)(tus + (id_of(I0, I1, i) * 128u + joff)); }
#define PU_COMPUTE(T, ROW, HA, HB) { int res[16]; \
    _Pragma("unroll") for (int i = 0; i < 16; ++i) { \
        int da = __builtin_amdgcn_sdot8((int)ROW[i].x, (int)HA.x, 0, false); da = __builtin_amdgcn_sdot8((int)ROW[i].y, (int)HA.y, da, false); da = __builtin_amdgcn_sdot8((int)ROW[i].z, (int)HA.z, da, false); da = __builtin_amdgcn_sdot8((int)ROW[i].w, (int)HA.w, da, false); \
        int db = __builtin_amdgcn_sdot8((int)ROW[i].x, (int)HB.x, 0, false); db = __builtin_amdgcn_sdot8((int)ROW[i].y, (int)HB.y, db, false); db = __builtin_amdgcn_sdot8((int)ROW[i].z, (int)HB.z, db, false); db = __builtin_amdgcn_sdot8((int)ROW[i].w, (int)HB.w, db, false); \
        res[i] = red8_i((da << 4) + db); } \
      \
      \
    int lo_, hi_; { int r0 = res[0], r1 = res[1], r2 = res[2], r3 = res[3], r4 = res[4], r5 = res[5], r6 = res[6], r7 = res[7], r8 = res[8], r9 = res[9], r10 = res[10], r11 = res[11], r12 = res[12], r13 = res[13], r14 = res[14], r15 = res[15]; \
      asm volatile("" : "+v"(r0), "+v"(r1), "+v"(r2), "+v"(r3), "+v"(r4), "+v"(r5), "+v"(r6), "+v"(r7), "+v"(r8), "+v"(r9), "+v"(r10), "+v"(r11), "+v"(r12), "+v"(r13), "+v"(r14), "+v"(r15)); \
      const int a00 = jb0 ? r2 : r0, a01 = jb0 ? r3 : r1, a10 = jb0 ? r6 : r4, a11 = jb0 ? r7 : r5, a20 = jb0 ? r10 : r8, a21 = jb0 ? r11 : r9, a30 = jb0 ? r14 : r12, a31 = jb0 ? r15 : r13; \
      const int b00 = jb1 ? a10 : a00, b01 = jb1 ? a11 : a01, b10 = jb1 ? a30 : a20, b11 = jb1 ? a31 : a21; \
      lo_ = jb2 ? b10 : b00; hi_ = jb2 ? b11 : b01; }     \
    *(GAS unsigned*)(PART + ((size_t)s * R + (T)) * 64 + lane) = __builtin_bit_cast(unsigned, __builtin_amdgcn_cvt_pkrtz((float)lo_ * 0.015625f, (float)hi_ * 0.015625f)); }
__device__ __forceinline__ void ph_peer_u(const Args& a, int layer, int row_lo, const XInfo xi, int lane, int wave) {
    unsigned char* ws = a.ws;
    const unsigned short* E = (const unsigned short*)(ws + WS_EIDX); const unsigned char* TU = ws + WS_TABU + (size_t)layer * NEXP * 512; const unsigned char* H8 = ws + WS_H8;
    unsigned* PART = (unsigned*)(ws + WS_PART);
    const int j = lane & 7, st = 2 * xi.nloc * NWAVES; const int rank_ = xi.rank;
    const int gb4 = (lane & ~7) << 2, jb4 = j << 4;
    const bool jb0 = (j & 1) != 0, jb1 = (j & 2) != 0, jb2 = (j & 4) != 0;
    for (int u = xi.pj; u < 8; u += xi.nx) {
        const int s = u >> 1;
        const unsigned char* tus = TU + (size_t)s * (NEXP * 128); const unsigned joff = (unsigned)j * 16u;
        const int hoff = ((lane & 32) ? 512 : 0) + 128 * s + 4 * (lane & 31);
        int t = row_lo + rank_ * NWAVES + wave + (u & 1) * (st >> 1);
        if (t >= R) continue;
        v4u ia0, ia1, ha, hb, ib0, ib1, ha2, hb2, rowA[16], rowB[16]; unsigned wa, xa, wb, xb;
        PU_LOAD_RAW(t, wa, xa) PU_LOAD_RAW(t + st, wb, xb)
        PU_EXPAND(wa, xa, ia0, ia1, ha, hb)
        PU_LOAD_ROWS(rowA, ia0, ia1)
        PU_LOAD_RAW(t + 2 * st, wa, xa)
#pragma unroll 1
        for (; t < R; t += 2 * st) {
            PU_EXPAND(wb, xb, ib0, ib1, ha2, hb2)
            PU_LOAD_ROWS(rowB, ib0, ib1)
            PU_LOAD_RAW(t + 3 * st, wb, xb)
            asm volatile("" ::: "memory");
            PU_COMPUTE(t, rowA, ha, hb)
            if (t + st < R) {
                PU_EXPAND(wa, xa, ia0, ia1, ha, hb)
                PU_LOAD_ROWS(rowA, ia0, ia1)
                PU_LOAD_RAW(t + 4 * st, wa, xa)
                asm volatile("" ::: "memory");
                PU_COMPUTE(t + st, rowB, ha2, hb2)
            }
        }
    }
}
__device__ __forceinline__ void ph_peer_c(const Args& a, int layer, int row_lo, LAS unsigned char* L, int tid, int lane, int gw, int NGW) {
    unsigned char* ws = a.ws;
    const unsigned short* E = (const unsigned short*)(ws + WS_EIDX); const float* egate = (const float*)(ws + WS_GATE); const unsigned short* PART = (const unsigned short*)(ws + WS_PART);
    const float* SU = (const float*)(ws + WS_SCALE) + (size_t)layer * NEXP; const float* SV = (const float*)(ws + WS_SCALE) + (size_t)(2 + layer) * NEXP;
    const float* hsc = (const float*)(ws + WS_HSC); signed char* COEF = (signed char*)(ws + WS_COEF); float* CSC = (float*)(ws + WS_CSUM);
    { LAS v4u* Ls = (LAS v4u*)L;
#pragma unroll
      for (int i = 0; i < 8; ++i) { Ls[tid + 512 * i] = *(const GAS v4u*)(SU + 4 * (tid + 512 * i)); Ls[4096 + tid + 512 * i] = *(const GAS v4u*)(SV + 4 * (tid + 512 * i)); }
      __syncthreads(); }
    const LAS float* SUl = (const LAS float*)L; const LAS float* SVl = SUl + NEXP;
    constexpr int CR = 6;
    for (int t0 = row_lo + gw; t0 < R; t0 += CR * NGW) {
        float S[CR][2]; int e[CR][2]; float gt[CR][2], hs[CR], su[CR][2], sv[CR][2];
#pragma unroll
        for (int q = 0; q < CR; ++q) { const int t = t0 + q * NGW < R ? t0 + q * NGW : t0; hs[q] = hsc[t];
            float a0 = 0.f, a1 = 0.f;
#pragma unroll
            for (int sl = 0; sl < 4; ++sl) { typedef _Float16 h2_t __attribute__((ext_vector_type(2)));
                const h2_t w = __builtin_bit_cast(h2_t, *(const GAS unsigned*)(PART + ((size_t)sl * R + t) * 128 + 2 * lane)); a0 += (float)w[0]; a1 += (float)w[1]; }
            S[q][0] = a0 * 64.0f; S[q][1] = a1 * 64.0f;
            const unsigned ew = *(const GAS unsigned*)(E + (size_t)t * 128 + 2 * lane); e[q][0] = (int)(ew & 0xffffu); e[q][1] = (int)(ew >> 16);
            const f32x2v gw2 = *(const GAS f32x2v*)(egate + (size_t)t * 128 + 2 * lane); gt[q][0] = gw2.x; gt[q][1] = gw2.y; }
#pragma unroll
        for (int q = 0; q < CR; ++q)
#pragma unroll
            for (int hh = 0; hh < 2; ++hh) { su[q][hh] = SUl[e[q][hh]]; sv[q][hh] = SVl[e[q][hh]]; }
#pragma unroll
        for (int q = 0; q < CR; ++q) { const int t = t0 + q * NGW; if (t < R) {
            float c[2];
#pragma unroll
            for (int hh = 0; hh < 2; ++hh) { float z = su[q][hh] * S[q][hh]; asm volatile("" : "+v"(z));
                z *= hs[q]; c[hh] = gelu_tanh(z) * gt[q][hh] * sv[q][hh]; }
            const float mx = fmaxf(wave_max(fmaxf(fabsf(c[0]), fabsf(c[1]))), 1e-30f), inv = 127.0f * __builtin_amdgcn_rcpf(mx);
            int q0 = (int)rintf(c[0] * inv), q1 = (int)rintf(c[1] * inv); q0 = q0 < -127 ? -127 : (q0 > 127 ? 127 : q0); q1 = q1 < -127 ? -127 : (q1 > 127 ? 127 : q1);
            *(GAS unsigned short*)(COEF + (size_t)t * 128 + 2 * lane) = (unsigned short)((q0 & 255) | ((q1 & 255) << 8));
            if (lane == 0) ((GAS float*)CSC)[t] = mx * (1.0f / 127.0f); } }
    }
}
#define PV_BLOCK(r0, r1, r2, r3, cw, A0, A1, A2, A3) { \
    const unsigned pa_ = __builtin_amdgcn_perm(r1, r0, 0x05010400u), pb_ = __builtin_amdgcn_perm(r1, r0, 0x07030602u), pc_ = __builtin_amdgcn_perm(r3, r2, 0x05010400u), pd_ = __builtin_amdgcn_perm(r3, r2, 0x07030602u); \
    A0 = __builtin_amdgcn_sdot4((int)__builtin_amdgcn_perm(pc_, pa_, 0x05040100u), (int)(cw), A0, false); A1 = __builtin_amdgcn_sdot4((int)__builtin_amdgcn_perm(pc_, pa_, 0x07060302u), (int)(cw), A1, false); \
    A2 = __builtin_amdgcn_sdot4((int)__builtin_amdgcn_perm(pd_, pb_, 0x05040100u), (int)(cw), A2, false); A3 = __builtin_amdgcn_sdot4((int)__builtin_amdgcn_perm(pd_, pb_, 0x07060302u), (int)(cw), A3, false); }
#define PV_BLOCK4(r0, r1, r2, r3, cw, ACC, B) { \
    const unsigned pa_ = __builtin_amdgcn_perm(r1, r0, 0x05010400u), pb_ = __builtin_amdgcn_perm(r1, r0, 0x07030602u), pc_ = __builtin_amdgcn_perm(r3, r2, 0x05010400u), pd_ = __builtin_amdgcn_perm(r3, r2, 0x07030602u); \
    const unsigned t0_ = __builtin_amdgcn_perm(pc_, pa_, 0x05040100u), t1_ = __builtin_amdgcn_perm(pc_, pa_, 0x07060302u), t2_ = __builtin_amdgcn_perm(pd_, pb_, 0x05040100u), t3_ = __builtin_amdgcn_perm(pd_, pb_, 0x07060302u); \
    ACC[(B) + 0] = __builtin_amdgcn_sdot4((int)(t0_ & 0x0F0F0F0Fu), (int)(cw), ACC[(B) + 0], false); ACC[(B) + 4] = __builtin_amdgcn_sdot4((int)t0_, (int)(cw), ACC[(B) + 4], false); \
    ACC[(B) + 1] = __builtin_amdgcn_sdot4((int)(t1_ & 0x0F0F0F0Fu), (int)(cw), ACC[(B) + 1], false); ACC[(B) + 5] = __builtin_amdgcn_sdot4((int)t1_, (int)(cw), ACC[(B) + 5], false); \
    ACC[(B) + 2] = __builtin_amdgcn_sdot4((int)(t2_ & 0x0F0F0F0Fu), (int)(cw), ACC[(B) + 2], false); ACC[(B) + 6] = __builtin_amdgcn_sdot4((int)t2_, (int)(cw), ACC[(B) + 6], false); \
    ACC[(B) + 3] = __builtin_amdgcn_sdot4((int)(t3_ & 0x0F0F0F0Fu), (int)(cw), ACC[(B) + 3], false); ACC[(B) + 7] = __builtin_amdgcn_sdot4((int)t3_, (int)(cw), ACC[(B) + 7], false); }
#define PV_BLOCK4F(r0, r1, r2, r3, cw, ACC, B, INIT) { \
    const unsigned pa_ = __builtin_amdgcn_perm(r1, r0, 0x05010400u), pb_ = __builtin_amdgcn_perm(r1, r0, 0x07030602u), pc_ = __builtin_amdgcn_perm(r3, r2, 0x05010400u), pd_ = __builtin_amdgcn_perm(r3, r2, 0x07030602u); \
    const unsigned t0_ = __builtin_amdgcn_perm(pc_, pa_, 0x05040100u), t1_ = __builtin_amdgcn_perm(pc_, pa_, 0x07060302u), t2_ = __builtin_amdgcn_perm(pd_, pb_, 0x05040100u), t3_ = __builtin_amdgcn_perm(pd_, pb_, 0x07060302u); \
    asm("v_dot4_i32_i8 %0, %1, %2, %3" : "=v"(ACC[(B) + 0]) : "v"((int)(t0_ & 0x0F0F0F0Fu)), "v"((int)(cw)), "v"(INIT)); asm("v_dot4_i32_i8 %0, %1, %2, %3" : "=v"(ACC[(B) + 4]) : "v"((int)(t0_)), "v"((int)(cw)), "v"(INIT)); \
    asm("v_dot4_i32_i8 %0, %1, %2, %3" : "=v"(ACC[(B) + 1]) : "v"((int)(t1_ & 0x0F0F0F0Fu)), "v"((int)(cw)), "v"(INIT)); asm("v_dot4_i32_i8 %0, %1, %2, %3" : "=v"(ACC[(B) + 5]) : "v"((int)(t1_)), "v"((int)(cw)), "v"(INIT)); \
    asm("v_dot4_i32_i8 %0, %1, %2, %3" : "=v"(ACC[(B) + 2]) : "v"((int)(t2_ & 0x0F0F0F0Fu)), "v"((int)(cw)), "v"(INIT)); asm("v_dot4_i32_i8 %0, %1, %2, %3" : "=v"(ACC[(B) + 6]) : "v"((int)(t2_)), "v"((int)(cw)), "v"(INIT)); \
    asm("v_dot4_i32_i8 %0, %1, %2, %3" : "=v"(ACC[(B) + 3]) : "v"((int)(t3_ & 0x0F0F0F0Fu)), "v"((int)(cw)), "v"(INIT)); asm("v_dot4_i32_i8 %0, %1, %2, %3" : "=v"(ACC[(B) + 7]) : "v"((int)(t3_)), "v"((int)(cw)), "v"(INIT)); }
#define PV_LOAD_RAW(T, IW, CW) { const int t_ = (T) < R ? (T) : row_lo; IW = *(const GAS unsigned*)(E + (size_t)t_ * 128 + 2 * lane); CW = *(const GAS unsigned*)(lane < 32 ? (const unsigned char*)COEF + (size_t)t_ * 128 + 4 * lane : (const unsigned char*)(CSC + t_)); }
#define PV_EXPAND(IW, CW, I0, I1, CQ, CS) { CS = __builtin_bit_cast(float, __builtin_amdgcn_readlane((int)CW, 32)); _Pragma("unroll") for (int c = 0; c < 4; ++c) { I0[c] = (unsigned)__builtin_amdgcn_ds_bpermute(gb4 + 4 * c, (int)IW); I1[c] = (unsigned)__builtin_amdgcn_ds_bpermute(gb4 + 16 + 4 * c, (int)IW); \
    CQ[c] = (unsigned)__builtin_amdgcn_ds_bpermute(cb4 + 4 * c, (int)CW); } }
#define PV_LOAD_ROWS(ROW, I0, I1) { _Pragma("unroll") for (int i = 0; i < 16; ++i) ROW[i] = *(const GAS v4u*)(tvs + (id_of(I0, I1, i) * 128u + joff)); }
#define PV_LOAD_X(T, XQ) { const int t_ = (T) < R ? (T) : row_lo; XQ = *(const GAS unsigned long long*)(X + (size_t)t_ * D + s * 256 + j * 32 + 4 * g); }
#define PV_COMPUTE(T, ROW, CQ, CS, XQ) { const int t_ = (T); \
    bf16* x = X + (size_t)t_ * D + s * 256 + j * 32 + 4 * g; { const int mb_ = row_modb(t_); if (mb_ != mbcur) { mbcur = mb_; gv = *(const GAS f32x4*)(modsL + (size_t)mb_ * NMOD + 5 * D + s * 256 + j * 32 + 4 * g); } }     \
    const unsigned long long xq_ = (XQ); const float cs = (CS) * live * ((g & 1) ? 0.0625f : 1.0f); \
      \
    const int k8n_ = -8 * (__builtin_amdgcn_sdot4(0x01010101, (int)CQ[0], 0, false) + __builtin_amdgcn_sdot4(0x01010101, (int)CQ[1], 0, false) + __builtin_amdgcn_sdot4(0x01010101, (int)CQ[2], 0, false) + __builtin_amdgcn_sdot4(0x01010101, (int)CQ[3], 0, false)); \
    int acc[32]; \
    _Pragma("unroll") for (int d = 0; d < 4; ++d) PV_BLOCK4F(ROW[0][d], ROW[1][d], ROW[2][d], ROW[3][d], CQ[0], acc, 8 * d, k8n_) \
    _Pragma("unroll") for (int m = 1; m < 4; ++m) _Pragma("unroll") for (int d = 0; d < 4; ++d) PV_BLOCK4(ROW[4 * m][d], ROW[4 * m + 1][d], ROW[4 * m + 2][d], ROW[4 * m + 3][d], CQ[m], acc, 8 * d) \
    _Pragma("unroll") for (int d = 0; d < 4; ++d) _Pragma("unroll") for (int c = 0; c < 4; ++c) acc[8 * d + 4 + c] -= acc[8 * d + c];     \
    int r16[16], r8[8]; \
    _Pragma("unroll") for (int b = 0; b < 16; ++b) { auto rr = __builtin_amdgcn_permlane32_swap((unsigned)acc[b], (unsigned)acc[b + 16], false, false); r16[b] = (int)(rr[0] + rr[1]); } \
    _Pragma("unroll") for (int c = 0; c < 8; ++c) { auto rr = __builtin_amdgcn_permlane16_swap((unsigned)r16[c], (unsigned)r16[c + 8], false, false); r8[c] = (int)(rr[0] + rr[1]); } \
    const bool up_ = (lane & 8) != 0; int o_[4]; \
    _Pragma("unroll") for (int k = 0; k < 4; ++k) { int ka = r8[k], kb = r8[4 + k]; asm volatile("" : "+v"(ka), "+v"(kb)); o_[k] = (up_ ? kb : ka) + dpp_i<0x128>(up_ ? ka : kb); } \
    const unsigned xlo_ = (unsigned)xq_, xhi_ = (unsigned)(xq_ >> 32); \
    const float x0_ = bflo(xlo_) + gv.x * (cs * (float)o_[0]), x1_ = bfhi(xlo_) + gv.y * (cs * (float)o_[1]), x2_ = bflo(xhi_) + gv.z * (cs * (float)o_[2]), x3_ = bfhi(xhi_) + gv.w * (cs * (float)o_[3]); \
    *(GAS unsigned long long*)x = (unsigned long long)pk2(x0_, x1_) | ((unsigned long long)pk2(x2_, x3_) << 32); }
__device__ __forceinline__ void ph_peer_v(const Args& a, int layer, int row_lo, const XInfo xi, int lane, int wave, float live) {
    unsigned char* ws = a.ws;
    const unsigned short* E = (const unsigned short*)(ws + WS_EIDX); const unsigned char* TV = ws + WS_TABV + (size_t)layer * NEXP * 512;
    const signed char* COEF = (const signed char*)(ws + WS_COEF); const float* CSC = (const float*)(ws + WS_CSUM);
    const float* modsL = (const float*)(ws + WS_MODS) + (size_t)layer * 5 * NMOD;
    bf16* X = (bf16*)(ws + WS_X);
    const int g = lane >> 3, j = lane & 7, st = 2 * xi.nloc * NWAVES;
    const int gb4 = (lane & ~7) << 2, cb4 = g << 4;
    for (int u = xi.pj; u < 8; u += xi.nx) {
        const int s = u >> 1;
        const unsigned char* tvs = TV + (size_t)s * (NEXP * 128); const unsigned joff = (unsigned)j * 16u;
        int t = row_lo + xi.rank * NWAVES + wave + (u & 1) * (st >> 1);
        if (t >= R) continue;
        v4u ia0, ia1, ca, ib0, ib1, cb, rowA[16], rowB[16]; unsigned wa, xa, wb, xb;
        int mbcur = -1; f32x4 gv = {0.f, 0.f, 0.f, 0.f}; float csa, csb; unsigned long long xqa, xqb;
        PV_LOAD_RAW(t, wa, xa) PV_LOAD_RAW(t + st, wb, xb)
        PV_EXPAND(wa, xa, ia0, ia1, ca, csa)
        PV_LOAD_ROWS(rowA, ia0, ia1) PV_LOAD_X(t, xqa)
        PV_LOAD_RAW(t + 2 * st, wa, xa)
#pragma unroll 1
        for (; t < R; t += 2 * st) {
            PV_EXPAND(wb, xb, ib0, ib1, cb, csb)
            PV_LOAD_ROWS(rowB, ib0, ib1) PV_LOAD_X(t + st, xqb)
            PV_LOAD_RAW(t + 3 * st, wb, xb)
            asm volatile("" ::: "memory");
            PV_COMPUTE(t, rowA, ca, csa, xqa)
            if (t + st < R) {
                PV_EXPAND(wa, xa, ia0, ia1, ca, csa)
                PV_LOAD_ROWS(rowA, ia0, ia1) PV_LOAD_X(t + 2 * st, xqa)
                PV_LOAD_RAW(t + 4 * st, wa, xa)
                asm volatile("" ::: "memory");
                PV_COMPUTE(t + st, rowB, cb, csb, xqb)
            }
        }
    }
}
constexpr int NSUB = 11;
constexpr int N_PHASES = 2 + NSUB * DEPTH;
__global__ void __launch_bounds__(NWAVES * 64, 2) mk_fwd(Args a) {
    extern __shared__ __attribute__((aligned(16))) unsigned char lds[];
    LAS unsigned char* L = (LAS unsigned char*)lds;
    volatile LAS unsigned* MISC = (volatile LAS unsigned*)(L + MISC_OFF);
    const int G = gridDim.x; const int bx = blockIdx.x; const int vcu = (G % 8 == 0) ? (bx % 8) * (G / 8) + bx / 8 : bx;
    const int NGW = G * NWAVES;
    unsigned char* ws = a.ws;
    for (int u = threadIdx.x; u < 512 / 4; u += NWAVES * 64) ((LAS unsigned*)(L + MISC_OFF))[u] = 0u;
    __syncthreads();
    const int wave0 = __builtin_amdgcn_readfirstlane((int)threadIdx.x >> 6);
    const bool multi = (a.ph_hi - a.ph_lo) > 1;
    XcdBarrier bar; bar.bar = (unsigned*)(ws + WS_CTL) + CW_BAR; bar.x = 0; bar.st = nullptr;
    if (multi) bar = xcd_barrier_post((unsigned*)(ws + WS_CTL) + CW_BAR, MISC + 8);
    if (threadIdx.x == 0) MISC[16] = xb_add((unsigned*)(ws + WS_CTL) + CW_RANK + 64 * xb_xcc_id(), 1u);
const int ph_lo_ = a.ph_lo, ph_hi_ = a.ph_hi;
#pragma unroll 1
#ifdef EXP_NOH8
#define EXPH8 ((phx % (REP_N + 1)) != 0)
#else
#define EXPH8 false
#endif
#ifndef REP_PH
#define REP_PH -1
#define REP_N 0
#endif
    for (int phx = ph_lo_ * (REP_N + 1); phx < ph_hi_ * (REP_N + 1); ++phx) {
        int ph = phx / (REP_N + 1);
        if (ph != REP_PH && (phx % (REP_N + 1)) != 0) continue;
        unsigned char* ws = a.ws; asm volatile("" : "+s"(ws));
        const float* mods = (const float*)(ws + WS_MODS);
        bf16* XN = (bf16*)(ws + WS_XN); bf16* P = (bf16*)(ws + WS_P); bf16* Y = (bf16*)(ws + WS_Y);
        bf16* X = (bf16*)(ws + WS_X);
#define TID (lane_now() + wave0 * 64)
#define LANE lane_now()
        const int wave = wave0, gw = vcu * NWAVES + wave0;
#ifdef ONLY_SUB
#define SUBON(x) ((x) == ONLY_SUB)
#else
#define SUBON(x) true
#endif
#ifdef EXP_EMPTY
        if ((phx % (REP_N + 1)) != 0) {} else
#endif
        if (ph == 0 && SUBON(100)) ph_prologue(a, L, TID, LANE, wave, vcu, G);
        else if (ph == 1 && SUBON(101)) { ph_norm(a.in[I_CTX], a.in[I_X], nullptr, a.in[I_N1G], mods, 0, 1, XN, nullptr, (float*)(ws + WS_HSC), 0, gw, NGW, LANE);
            ph_wq8(ws, WS_WQ, WS_WQ8, WS_WQS, gw, NGW, LANE); ph_wq8(ws, WS_WIN, WS_WIN8, WS_WINS, gw, NGW, LANE); }
        else {
            const int layer = (ph - 2) / NSUB, sub = (ph - 2) % NSUB; const bool last = layer == DEPTH - 1;
            const float* modsL = mods + (size_t)layer * 5 * NMOD;
            const int rlo2 = last ? R_CTX : 0;
            if (sub == 0 && SUBON(0)) {
                const bf16* Wt = (const bf16*)(ws + WS_WIN) + (size_t)layer * D_IN * D;
                bf16* Qb_ = (bf16*)(ws + WS_Q); bf16* Kb_ = (bf16*)(ws + WS_K); bf16* Vb_ = (bf16*)(ws + WS_V); const float* rope_ = (const float*)(ws + WS_ROPE);
                const bf16* A8 = (const bf16*)(ws + WS_XN); const bf16* W8 = (const bf16*)(ws + WS_WIN8 + (size_t)layer * D_IN * D);
                const float* rsc = (const float*)(ws + WS_HSC); const float* csc = (const float*)(ws + WS_WINS) + layer * D_IN;
                { pg8::Gemm g{A8, W8, R_CTX, D_IN, D}; pg8::EpiWin8 E{pg8::EpiBf16<0>{P, D_IN, nullptr, 0, 0, 1.f, 128, 1}, rsc, csc, Qb_, Kb_, Vb_, rope_, 0, R_CTX, QSCALE};
                  pg8::OrderHalf S; S.init(R_CTX / 128, last ? 1 : 8, last ? 7 : 0, G, bx); pg8::gemm_phase<pg8::EpiWin8, pg8::OrderHalf, true, true, true, true>(L, g, S, E, TID); }
                { pg8::Gemm g{(const bf16*)((const unsigned char*)A8 + (size_t)R_CTX * D), W8, R_LAT, D_IN, D}; pg8::EpiWin8 E{pg8::EpiBf16<0>{P + (size_t)R_CTX * D_IN, D_IN, nullptr, 0, 0, 1.f}, rsc, csc, Qb_, Kb_, Vb_, rope_, R_CTX, R_CTX, QSCALE};
                  pg8::StaticOrder S; S.init(R_LAT, D_IN, G, bx); pg8::gemm_phase<pg8::EpiWin8, pg8::StaticOrder, true, true, false, true>(L, g, S, E, TID); }
                if (layer == 0) tail_quant(a, ws, 0, bx, G, wave, LANE);
            } else if (sub == 1 && SUBON(1)) {
                if (vcu & 1) { ph_attn(a, layer, last, L, TID, LANE, wave, vcu, G); __syncthreads(); ph_post(a, layer, last, L, TID, LANE, wave, vcu, G); }
                else { ph_post(a, layer, last, L, TID, LANE, wave, vcu, G); __syncthreads(); ph_attn(a, layer, last, L, TID, LANE, wave, vcu, G); }
            }
            else if (sub == 2) continue;
            else if (sub == 3 && SUBON(3)) {
                const bf16* Wt = (const bf16*)(ws + WS_WOUT) + (size_t)layer * D * D;
                { pg8::Gemm g{Y + (size_t)R_CTX * D, Wt, R_LAT, D, D}; pg8::StaticOrder S; S.init(R_LAT, D, G, bx);
                  if (layer == 0) { pg8::EpiResid<true> E{a.in[I_CTX], a.in[I_X], X, modsL + 2 * D, (const float*)(ws + WS_SSQ), (LAS float*)(L + 131072), R_CTX};
                      pg8::gemm_phase<pg8::EpiResid<true>, pg8::StaticOrder, true, true>(L, g, S, E, TID); }
                  else { pg8::EpiResid<false> E{nullptr, nullptr, X, modsL + 2 * D, (const float*)(ws + WS_SSQ), (LAS float*)(L + 131072), R_CTX};
                      pg8::gemm_phase<pg8::EpiResid<false>, pg8::StaticOrder, true, true>(L, g, S, E, TID); } }
                if (layer == 0) { pg8::Gemm g{Y, Wt, R_CTX, D, D}; pg8::OrderHalf S; S.init(R_CTX / 128, 4, 0, G, bx);
                    pg8::EpiResid<true> E{a.in[I_CTX], a.in[I_X], X, modsL + 2 * D, (const float*)(ws + WS_SSQ), (LAS float*)(L + 131072), 0, 128, 1};
                    pg8::gemm_phase<pg8::EpiResid<true>, pg8::OrderHalf, true, true, true>(L, g, S, E, TID);
                    tail_quant(a, ws, 1, bx, G, wave, LANE); }
            } else if (sub == 4 && SUBON(4)) ph_norm(nullptr, nullptr, X, a.in[I_N2G] + layer * D, modsL, 3, 4, XN, (signed char*)(ws + WS_H8), (float*)(ws + WS_HSC), rlo2, gw, NGW, LANE);
            else if (sub == 5 && SUBON(5)) {
                const bf16* A8 = (const bf16*)(ws + WS_XN); const bf16* Wt = (const bf16*)(ws + WS_WQ8 + (size_t)layer * 2048 * D);
                const float* rsc = (const float*)(ws + WS_HSC); const float* csc = (const float*)(ws + WS_WQS) + layer * 2048;
                if (layer == 0) { pg8::Gemm g{A8, Wt, R_CTX, 2048, D}; pg8::OrderHalf S; S.init(R_CTX / 128, 8, 0, G, bx);
                    pg8::EpiQ8 E{P, rsc, csc, 0, 128, 1};
                    pg8::gemm_phase<pg8::EpiQ8, pg8::OrderHalf, true, true, true, true>(L, g, S, E, TID); }
                { pg8::Gemm g{(const bf16*)((const unsigned char*)A8 + (size_t)R_CTX * D), Wt, R_LAT, 2048, D}; pg8::StaticOrder S; S.init(R_LAT, 2048, G, bx);
                  pg8::EpiQ8 E{P, rsc, csc, R_CTX};
                  pg8::gemm_phase<pg8::EpiQ8, pg8::StaticOrder, true, true, false, true>(L, g, S, E, TID); }
                if (layer == 0) { tail_quant(a, ws, 2, bx, G, wave, LANE); }
            } else if (sub == 6 && SUBON(6)) ph_topk(a, layer, rlo2, L, TID, LANE, wave, vcu, G);
            else if (sub >= 7 && sub <= 9 && SUBON(7)) {
                XInfo xi; { const unsigned mask = MISC[10], myx = xb_xcc_id(); xi.pj = __builtin_popcount(mask & ((1u << myx) - 1u)); xi.nx = (int)MISC[9]; xi.nloc = (int)MISC[8]; xi.rank = (int)MISC[16];
                            if (xi.nx < 1) xi.nx = 1; if (xi.nloc < 1) xi.nloc = 1; }
                if (sub == 7) { if (layer == 0 && DEPTH > 1) quant_rows(a, ws, NEXP + gw, 2 * NEXP, NGW, LANE);
                    ph_peer_u(a, layer, rlo2, xi, LANE, wave); }
                else if (sub == 8) ph_peer_c(a, layer, rlo2, L, TID, LANE, gw, NGW);
                else { if (layer == 0 && DEPTH > 1) quant_rows(a, ws, 3 * NEXP + gw, 4 * NEXP, NGW, LANE);
                    ph_peer_v(a, layer, rlo2, xi, LANE, wave, (phx % (REP_N + 1)) == 0 ? 1.0f : 0.0f); }
            } else if (sub == 10 && SUBON(10)) {
                if (!last) ph_norm(nullptr, nullptr, X, a.in[I_N1G] + (layer + 1) * D, mods + (size_t)(layer + 1) * 5 * NMOD, 0, 1, XN, nullptr, (float*)(ws + WS_HSC), 0, gw, NGW, LANE);
                else ph_final(X, a.out, a.in[I_FING], gw, NGW, LANE);
            }
        }
        if (phx + 1 < ph_hi_ * (REP_N + 1)) { int tb; asm volatile("v_mbcnt_lo_u32_b32 %0, -1, 0\n\tv_mbcnt_hi_u32_b32 %0, -1, %0" : "=v"(tb)); xcd_barrier(bar, tb + wave0 * 64); }
    }
}


#ifndef MK_PER_PHASE
#define MK_PER_PHASE 0
#endif
extern "C" void kernel_launch(void* const* d_in, const int* in_sizes, int n_in, void* d_out, int out_size, void* d_ws, size_t ws_size, hipStream_t stream) {
    static int grid = 0;
    if (grid == 0) {
        if (n_in != 21 || ws_size < WS_END) { fprintf(stderr, "kernel_launch: bad inputs (n_in %d, ws %zu)\n", n_in, ws_size); grid = -1; return; }
        int dev = 0, cus = 0;
        if (hipGetDevice(&dev) != hipSuccess || hipDeviceGetAttribute(&cus, hipDeviceAttributeMultiprocessorCount, dev) != hipSuccess) { grid = -1; return; }
        if (hipFuncSetAttribute((const void*)mk_fwd, hipFuncAttributeMaxDynamicSharedMemorySize, LDS_BYTES) != hipSuccess) { fprintf(stderr, "kernel_launch: hipFuncSetAttribute failed\n"); grid = -1; return; }
        grid = cus;
    }
    if (grid < 0) return;
    (void)hipMemsetAsync((char*)d_ws + WS_CTL, 0, CTL_ZERO_BYTES, stream);
    Args a{};
    for (int i = 0; i < 21; ++i) a.in[i] = (const float*)d_in[i];
    a.out = (float*)d_out; a.ws = (unsigned char*)d_ws;
#if MK_PER_PHASE
    for (int ph = 0; ph < N_PHASES; ++ph) { a.ph_lo = ph; a.ph_hi = ph + 1; hipLaunchKernelGGL(mk_fwd, dim3(grid), dim3(NWAVES * 64), LDS_BYTES, stream, a); }
#else
    a.ph_lo = 0; a.ph_hi = N_PHASES; hipLaunchKernelGGL(mk_fwd, dim3(grid), dim3(NWAVES * 64), LDS_BYTES, stream, a);
#endif
}
```
